# Optimizing an MI355X kernel written in HIP

```python
import math
import jax, jax.numpy as jnp
from jax import lax
import numpy as np

D_MODEL = 1024
BATCH = 8
SEQ = 2048
DEPTH = 1

MIX_WIDTH = D_MODEL
MLA_HEADS = 8
MLA_NOPE_DIM = 64
MLA_ROPE_DIM = 32
MLA_QK_DIM = MLA_NOPE_DIM + MLA_ROPE_DIM
MLA_V_DIM = 64
MLA_Q_RANK = 256
MLA_KV_RANK = 128
MLA_WIDTH = MLA_HEADS * MLA_V_DIM
CONV_CH = MIX_WIDTH - MLA_WIDTH
CONV_WIDTH = 31
CONV_PAD = (CONV_WIDTH - 1) // 2
ROPE_BASE = 10000.0
MEM_LEN = 256
MEM_HEADS = 4
MEM_HEAD_DIM = D_MODEL // MEM_HEADS
N_EXPERTS = 16
EXPERT_FF = 2048
CAPACITY_FACTOR = 2
Q_BLOCK = 128
NORM_EPS = 1e-5
DEEPNORM_ALPHA = (2.0 * DEPTH) ** 0.25
DEEPNORM_BETA = (8.0 * DEPTH) ** -0.25
SPLIT_Q = MLA_Q_RANK
SPLIT_KV = SPLIT_Q + MLA_KV_RANK
SPLIT_KR = SPLIT_KV + MLA_ROPE_DIM
IN_PROJ_WIDTH = SPLIT_KR + 2 * CONV_CH

kernel_name = "hybrid_mla_conformer_ecmoe_encoder"


def layer_norm(x, g, b):
    xf = x.astype(jnp.float32)
    mu = jnp.mean(xf, axis=-1, keepdims=True)
    var = jnp.mean(jnp.square(xf - mu), axis=-1, keepdims=True)
    y = (xf - mu) * lax.rsqrt(var + NORM_EPS) * g.astype(jnp.float32) + b.astype(jnp.float32)
    return y.astype(x.dtype)


def rms_norm(x, g):
    xf = x.astype(jnp.float32)
    y = xf * lax.rsqrt(jnp.mean(jnp.square(xf), axis=-1, keepdims=True) + NORM_EPS) * g.astype(jnp.float32)
    return y.astype(x.dtype)


def rotary(x, cos, sin):
    x1, x2 = jnp.split(x, 2, axis=-1)
    return jnp.concatenate([x1 * cos - x2 * sin, x2 * cos + x1 * sin], axis=-1)


def blocked_attention(q, k, v, scale):
    b, s, h, dq = q.shape
    nb = s // Q_BLOCK
    qb = q.reshape(b, nb, Q_BLOCK, h, dq).transpose(1, 0, 2, 3, 4)

    def one_block(qblk):
        sc = jnp.einsum('bqhd,bkhd->bhqk', qblk, k).astype(jnp.float32) * scale
        p = jax.nn.softmax(sc, axis=-1).astype(v.dtype)
        return jnp.einsum('bhqk,bkhd->bqhd', p, v)

    o = lax.map(one_block, qb)
    return o.transpose(1, 0, 2, 3, 4).reshape(b, s, h * v.shape[-1])


def parallel_mixer(x, positions, w_in, q_norm_g, w_uq, kv_norm_g, w_uk, w_uv,
                   conv_w, conv_b, conv_ln_g, conv_ln_b, w_o):
    b, s, _ = x.shape
    hcat = x @ w_in
    c_q = hcat[..., :SPLIT_Q]
    c_kv = hcat[..., SPLIT_Q:SPLIT_KV]
    k_rope = hcat[..., SPLIT_KV:SPLIT_KR]
    conv_in = hcat[..., SPLIT_KR:]

    q = (rms_norm(c_q, q_norm_g) @ w_uq).reshape(b, s, MLA_HEADS, MLA_QK_DIM)
    q_nope, q_rope = q[..., :MLA_NOPE_DIM], q[..., MLA_NOPE_DIM:]
    ckv = rms_norm(c_kv, kv_norm_g)
    k_nope = (ckv @ w_uk).reshape(b, s, MLA_HEADS, MLA_NOPE_DIM)
    v = (ckv @ w_uv).reshape(b, s, MLA_HEADS, MLA_V_DIM)
    inv_freq = ROPE_BASE ** (-jnp.arange(0, MLA_ROPE_DIM, 2, dtype=jnp.float32) / MLA_ROPE_DIM)
    ang = positions.astype(jnp.float32)[..., None] * inv_freq
    cos = jnp.cos(ang).astype(x.dtype)
    sin = jnp.sin(ang).astype(x.dtype)
    q_rope = rotary(q_rope, cos[:, :, None, :], sin[:, :, None, :])
    k_rope = rotary(k_rope, cos, sin)
    q_full = jnp.concatenate([q_nope, q_rope], axis=-1)
    k_full = jnp.concatenate(
        [k_nope, jnp.broadcast_to(k_rope[:, :, None, :], (b, s, MLA_HEADS, MLA_ROPE_DIM))], axis=-1)
    attn_out = blocked_attention(q_full, k_full, v, 1.0 / math.sqrt(MLA_QK_DIM))

    a, g = conv_in[..., :CONV_CH], conv_in[..., CONV_CH:]
    u = a * jax.nn.sigmoid(g)
    u = lax.conv_general_dilated(
        u, conv_w[:, None, :], window_strides=(1,), padding=[(CONV_PAD, CONV_PAD)],
        dimension_numbers=('NWC', 'WIO', 'NWC'), feature_group_count=CONV_CH) + conv_b
    u = jax.nn.silu(layer_norm(u, conv_ln_g, conv_ln_b))

    return jnp.concatenate([attn_out, u], axis=-1) @ w_o


def memory_cross_attention(x, mem, w_q, w_k, w_v, w_o):
    b, s, _ = x.shape
    m = mem.shape[1]
    q = (x @ w_q).reshape(b, s, MEM_HEADS, MEM_HEAD_DIM)
    k = (mem @ w_k).reshape(b, m, MEM_HEADS, MEM_HEAD_DIM)
    v = (mem @ w_v).reshape(b, m, MEM_HEADS, MEM_HEAD_DIM)
    sc = jnp.einsum('bshd,bmhd->bhsm', q, k).astype(jnp.float32) / math.sqrt(MEM_HEAD_DIM)
    p = jax.nn.softmax(sc, axis=-1).astype(v.dtype)
    o = jnp.einsum('bhsm,bmhd->bshd', p, v).reshape(b, s, D_MODEL)
    return o @ w_o


def expert_choice_moe(x, w_router, w_gate, w_up, w_down):
    b, s, d = x.shape
    cap = CAPACITY_FACTOR * s // N_EXPERTS
    affinity = jax.nn.softmax((x @ w_router).astype(jnp.float32), axis=-1)
    gate, idx = lax.top_k(affinity.transpose(0, 2, 1), cap)
    bidx = jnp.arange(b)[:, None, None]
    xs = x[bidx, idx]
    hid = jax.nn.silu(jnp.einsum('becd,edf->becf', xs, w_gate)) * jnp.einsum('becd,edf->becf', xs, w_up)
    y = jnp.einsum('becf,efd->becd', hid, w_down).astype(jnp.float32) * gate[..., None]
    out = jnp.zeros((b, s, d), jnp.float32).at[bidx, idx].add(y)
    return out.astype(x.dtype)


def setup_inputs(seed: int = 0) -> dict:
    key = jax.random.key(seed)
    ks = jax.random.split(key, 32)
    f32 = jnp.float32

    def nrm(k, shape, fan_in, scale=1.0):
        return jax.random.normal(k, shape, f32) * (scale * fan_in ** -0.5)

    def gain(k, shape):
        return 1.0 + 0.02 * jax.random.normal(k, shape, f32)

    def bias(k, shape):
        return 0.02 * jax.random.normal(k, shape, f32)

    L = DEPTH
    beta = DEEPNORM_BETA
    x = jax.random.normal(ks[0], (BATCH, SEQ, D_MODEL), f32)
    mem = jax.random.normal(ks[1], (BATCH, MEM_LEN, D_MODEL), f32)
    offs = jax.random.randint(ks[2], (BATCH, 1), 0, 4096)
    positions = (jnp.arange(SEQ, dtype=jnp.int32)[None, :] + offs).astype(jnp.int32)
    return {
        "x": x,
        "mem": mem,
        "positions": positions,
        "w_in": nrm(ks[3], (L, D_MODEL, IN_PROJ_WIDTH), D_MODEL),
        "q_norm_g": gain(ks[4], (L, MLA_Q_RANK)),
        "w_uq": nrm(ks[5], (L, MLA_Q_RANK, MLA_HEADS * MLA_QK_DIM), MLA_Q_RANK),
        "kv_norm_g": gain(ks[6], (L, MLA_KV_RANK)),
        "w_uk": nrm(ks[7], (L, MLA_KV_RANK, MLA_HEADS * MLA_NOPE_DIM), MLA_KV_RANK),
        "w_uv": nrm(ks[8], (L, MLA_KV_RANK, MLA_HEADS * MLA_V_DIM), MLA_KV_RANK, beta),
        "conv_w": nrm(ks[9], (L, CONV_WIDTH, CONV_CH), CONV_WIDTH),
        "conv_b": bias(ks[10], (L, CONV_CH)),
        "conv_ln_g": gain(ks[11], (L, CONV_CH)),
        "conv_ln_b": bias(ks[12], (L, CONV_CH)),
        "w_o": nrm(ks[13], (L, MIX_WIDTH, D_MODEL), MIX_WIDTH, beta),
        "ln1_g": gain(ks[14], (L, D_MODEL)),
        "ln1_b": bias(ks[15], (L, D_MODEL)),
        "xa_w_q": nrm(ks[16], (L, D_MODEL, D_MODEL), D_MODEL),
        "xa_w_k": nrm(ks[17], (L, D_MODEL, D_MODEL), D_MODEL),
        "xa_w_v": nrm(ks[18], (L, D_MODEL, D_MODEL), D_MODEL, beta),
        "xa_w_o": nrm(ks[19], (L, D_MODEL, D_MODEL), D_MODEL, beta),
        "ln2_g": gain(ks[20], (L, D_MODEL)),
        "ln2_b": bias(ks[21], (L, D_MODEL)),
        "w_router": nrm(ks[22], (L, D_MODEL, N_EXPERTS), D_MODEL),
        "w_gate": nrm(ks[23], (L, N_EXPERTS, D_MODEL, EXPERT_FF), D_MODEL),
        "w_up": nrm(ks[24], (L, N_EXPERTS, D_MODEL, EXPERT_FF), D_MODEL),
        "w_down": nrm(ks[25], (L, N_EXPERTS, EXPERT_FF, D_MODEL), EXPERT_FF, beta),
        "ln3_g": gain(ks[26], (L, D_MODEL)),
        "ln3_b": bias(ks[27], (L, D_MODEL)),
    }


def reference(x, mem, positions, w_in, q_norm_g, w_uq, kv_norm_g, w_uk, w_uv,
              conv_w, conv_b, conv_ln_g, conv_ln_b, w_o, ln1_g, ln1_b,
              xa_w_q, xa_w_k, xa_w_v, xa_w_o, ln2_g, ln2_b,
              w_router, w_gate, w_up, w_down, ln3_g, ln3_b):
    h = x
    for l in range(DEPTH):
        mix = parallel_mixer(h, positions, w_in[l], q_norm_g[l], w_uq[l], kv_norm_g[l], w_uk[l], w_uv[l],
                             conv_w[l], conv_b[l], conv_ln_g[l], conv_ln_b[l], w_o[l])
        h = layer_norm(DEEPNORM_ALPHA * h + mix, ln1_g[l], ln1_b[l])
        xa = memory_cross_attention(h, mem, xa_w_q[l], xa_w_k[l], xa_w_v[l], xa_w_o[l])
        h = layer_norm(DEEPNORM_ALPHA * h + xa, ln2_g[l], ln2_b[l])
        ff = expert_choice_moe(h, w_router[l], w_gate[l], w_up[l], w_down[l])
        h = layer_norm(DEEPNORM_ALPHA * h + ff, ln3_g[l], ln3_b[l])
    return h
```

```cpp
#include <hip/hip_runtime.h>
#include <cstdio>
#include <cstdint>
#include <cmath>

#define LAS __attribute__((address_space(3)))
#define GAS __attribute__((address_space(1)))
typedef _Float16 f16;
typedef _Float16 f16x2 __attribute__((ext_vector_type(2)));
typedef _Float16 f16x4 __attribute__((ext_vector_type(4)));
typedef _Float16 f16x8 __attribute__((ext_vector_type(8)));
typedef float f32x2 __attribute__((ext_vector_type(2)));
typedef float f32x4 __attribute__((ext_vector_type(4)));
typedef float f32x16 __attribute__((ext_vector_type(16)));
typedef unsigned u32x2 __attribute__((ext_vector_type(2)));
typedef unsigned u32x4 __attribute__((ext_vector_type(4)));
typedef short s16x4 __attribute__((ext_vector_type(4)));
typedef GAS unsigned gu32;

#ifndef MK_N_LAUNCHES
#define MK_N_LAUNCHES 1
#endif
#ifndef NAIVE_ATTN
#define NAIVE_ATTN 0
#endif

constexpr int NB = 8, SEQ = 2048, T = NB * SEQ, D = 1024;
constexpr int LDH = 1536;
constexpr int MEML = 256, MT = NB * MEML;
constexpr int NE = 16, FF = 2048, CAP = 256;
constexpr int CCH = 512, CW = 31, CPAD = 15;
constexpr float EPS = 1e-5f;
constexpr float ALPHA = 1.189207115002721f;
constexpr float LOG2E = 1.4426950408889634f;
constexpr float QSCALE = LOG2E * 0.10206207261596577f;
constexpr float XSCALE = LOG2E / 16.0f;
constexpr int NWAVES = 8, NTHR = 512, GRID = 256;

constexpr size_t MiB = 1ull << 20;
constexpr size_t WS_CTL = 0, CTL_BYTES = MiB;
constexpr size_t WS_WIN = 1 * MiB, WS_WUP = 4 * MiB, WS_WO = 6 * MiB, WS_XWQ = 8 * MiB, WS_XWK = 10 * MiB, WS_XWV = 12 * MiB, WS_XWO = 14 * MiB;
constexpr size_t WS_CS = 16 * MiB, WS_AFF = 19 * MiB, WS_SLOT = 20 * MiB, WS_TOK = 21 * MiB, WS_GATE = 21 * MiB + 512 * 1024, WS_MK = 22 * MiB, WS_MVT = 26 * MiB;
constexpr size_t WS_WGU = 32 * MiB, WS_WD = 160 * MiB, WS_HA = 224 * MiB;
constexpr size_t WS_XH = 288 * MiB, WS_MEMH = 320 * MiB, WS_HCAT = 324 * MiB, WS_Q = 372 * MiB, WS_K = 396 * MiB, WS_V = 420 * MiB, WS_AO = 436 * MiB;
constexpr size_t WS_PRE = 288 * MiB, WS_HH = 352 * MiB, WS_XQ = 384 * MiB, WS_P = 416 * MiB, WS_XO = 448 * MiB;
constexpr size_t WS_XS = 288 * MiB, WS_HID = 384 * MiB, WS_Y = 32 * MiB;
constexpr size_t WS_END = 512 * MiB;
constexpr int CW_TMO = 0, CW_BAR = 4096, CW_RS = 131072;

constexpr int RING_BYTES = 131072, MISC_OFF = RING_BYTES + 320, LDS_BYTES = 147456;

#define LDS_WAIT() asm volatile("s_waitcnt lgkmcnt(0)" ::: "memory")
#define VM_WAIT() asm volatile("s_waitcnt vmcnt(0)" ::: "memory")
#define RLX_AGENT __ATOMIC_RELAXED, __HIP_MEMORY_SCOPE_AGENT

__device__ __forceinline__ int opaque_tid() { int t; asm volatile("v_mov_b32_e32 %0, %1" : "=v"(t) : "v"(threadIdx.x)); return t; }
__device__ __forceinline__ unsigned pk_h2(float lo, float hi) { f32x2 v = {lo, hi}; f16x2 h = __builtin_convertvector(v, f16x2); return __builtin_bit_cast(unsigned, h); }
__device__ __forceinline__ float wave_sum(float v) {
#pragma unroll
    for (int o = 1; o < 64; o <<= 1) v += __shfl_xor(v, o);
    return v;
}

#define XB_TMO      128
#define XB_XCNT(j)  (256  + 64 * (j))
#define XB_XSUB(j)  (1280 + 64 * (j))
#define XB_XGEN(j)  (2304 + 64 * (j))
#define XB_TOP      3328
#define XB_TOPGEN   3392
#define XCD_BAR_WORDS 3456
#define XB_SPIN_CAP (1u << 18)
__device__ __forceinline__ unsigned xb_ld(unsigned* p)              { return __hip_atomic_load(p, __ATOMIC_RELAXED, __HIP_MEMORY_SCOPE_AGENT); }
__device__ __forceinline__ unsigned xb_add(unsigned* p, unsigned v) { return __hip_atomic_fetch_add(p, v, __ATOMIC_RELAXED, __HIP_MEMORY_SCOPE_AGENT); }
__device__ __forceinline__ unsigned xb_xcc_id() { return (unsigned)__builtin_amdgcn_s_getreg((3 << 11) | 20) & 0xFu; }
#define XB_SPIN(cond, bar) do { unsigned _sp = 0; while (cond) { __builtin_amdgcn_s_sleep(1); \
    if ((++_sp & 255u) == 0u) { if (xb_ld(&(bar)[XB_TMO])) break; if (_sp > XB_SPIN_CAP) { atomicAdd(&(bar)[XB_TMO], 1u); break; } } } } while (0)
struct XcdBarrier { unsigned* bar; unsigned x; volatile LAS unsigned* st; };
__device__ __forceinline__ XcdBarrier xcd_barrier_post(unsigned* bar, volatile LAS unsigned* st) {
    XcdBarrier b; b.bar = bar; b.x = xb_xcc_id(); b.st = st;
    if (threadIdx.x == 0) (void)xb_add(&bar[XB_XCNT(b.x)], 1u);
    return b;
}
__device__ __forceinline__ void xcd_barrier_complete(unsigned* bar, unsigned x, unsigned& nloc, unsigned& nx) {
    const unsigned G = gridDim.x * gridDim.y * gridDim.z;
    unsigned sum, cnt, mine, sp = 0u;
    for (;;) {
        sum = 0u; cnt = 0u; mine = 0u;
#pragma unroll
        for (unsigned j = 0; j < 16; ++j) { const unsigned c = xb_ld(&bar[XB_XCNT(j)]); sum += c; cnt += (c > 0u) ? 1u : 0u; mine = (j == x) ? c : mine; }
        if (sum == G) break;
        __builtin_amdgcn_s_sleep(1);
        if ((++sp & 255u) == 0u) { if (xb_ld(&bar[XB_TMO])) break; if (sp > XB_SPIN_CAP) { atomicAdd(&bar[XB_TMO], 1u); break; } }
    }
    nloc = mine > 0u ? mine : 1u; nx = cnt > 0u ? cnt : 1u;
}
__device__ __forceinline__ void xcd_barrier(const XcdBarrier& b) {
    asm volatile("s_waitcnt vmcnt(0)" ::: "memory");
    __syncthreads();
    if (threadIdx.x == 0) {
        unsigned* bar = b.bar;
        __builtin_amdgcn_s_waitcnt(0);
        unsigned nloc = b.st[0], nx = b.st[1];
        if (nloc == 0u) { xcd_barrier_complete(bar, b.x, nloc, nx); b.st[0] = nloc; b.st[1] = nx; }
        const unsigned old = xb_add(&bar[XB_XSUB(b.x)], 1u);
        const unsigned gen = old / nloc;
        if (old + 1u == (gen + 1u) * nloc) {
            __builtin_amdgcn_fence(__ATOMIC_RELEASE, "agent");
            asm volatile("s_waitcnt vmcnt(0)" ::: "memory");
            const unsigned og = xb_add(&bar[XB_TOP], 1u);
            const unsigned tg = og / nx;
            if (og + 1u == (tg + 1u) * nx) xb_add(&bar[XB_TOPGEN], 1u);
            else XB_SPIN(xb_ld(&bar[XB_TOPGEN]) == tg, bar);
            __builtin_amdgcn_fence(__ATOMIC_ACQUIRE, "agent");
            xb_add(&bar[XB_XGEN(b.x)], 1u);
            asm volatile("s_waitcnt vmcnt(0)" ::: "memory");
        } else {
            XB_SPIN(xb_ld(&bar[XB_XGEN(b.x)]) == gen, bar);
            __builtin_amdgcn_fence(__ATOMIC_ACQUIRE, "agent");
            asm volatile("s_waitcnt vmcnt(0)" ::: "memory");
        }
    }
    __syncthreads();
}

namespace pg8 {
constexpr int BM = 256, BK = 64, HALF = 128, HTB = HALF * BK * 2;
__host__ __device__ __forceinline__ int lds_byte(int r, int c) { const int st = (r >> 4) * 2 + (c >> 5), rr = r & 15, cc = c & 31, ob = rr * 64 + cc * 2; return st * 1024 + (ob ^ (((ob >> 9) & 1) << 5)); }
__host__ __device__ __forceinline__ void stage_rc(int b, int& R, int& C) { const int st = b / 1024, sb = b % 1024, swz = sb ^ (((sb >> 9) & 1) << 5); R = (st >> 1) * 16 + swz / 64; C = (st & 1) * 32 + (swz % 64) / 2; }
__host__ __device__ __forceinline__ int perm32(int rho) { const int n = rho >> 4, i = rho & 15; return 8 * (i >> 2) + 4 * n + (i & 3); }

struct Unit { int pm, pn, z; const char* A; const char* B; };
struct Gemm { int lda, ldb, K; };

template <class Epi, class Sched, bool ALIGN_EPI>
__device__ __forceinline__ void gemm_phase(LAS unsigned char* lds, const Gemm g, const Sched& S, const Epi& E) {
    const int tid = opaque_tid(), wid = __builtin_amdgcn_readfirstlane(tid >> 6), lane = tid & 63, wr = wid >> 2, wc = wid & 3, fr = lane & 15, fq = lane >> 4;
    const int K = g.K, nt = K / BK;
    unsigned voffA[2], voffB[2];
#pragma unroll
    for (int i = 0; i < 2; ++i) { int R, C; stage_rc(tid * 16 + i * 8192, R, C); const int Rb = Epi::PERM ? ((R & ~31) + perm32(R & 31)) : R;
        voffA[i] = (unsigned)(R * g.lda + C) * 2u; voffB[i] = (unsigned)(Rb * g.ldb + C) * 2u; }
    const size_t kstep = (size_t)(BK * 2);
    const size_t hstepA = (size_t)HALF * g.lda * 2, hstepB = (size_t)HALF * g.ldb * 2;
    const unsigned ldsw = (unsigned)wid * 1024u;
    const int aoff = lds_byte(wr * 64 + fr, fq * 8), boff = lds_byte(wc * 32 + fr, fq * 8);
#define PG8_SA(b, h) (((b) * 2 + (h)) * HTB)
#define PG8_SB(b, h) ((4 + (b) * 2 + (h)) * HTB)
#define PG8_STAGE(bufoff, gbase, voff) do { _Pragma("unroll") for (int _i = 0; _i < 2; ++_i) \
        __builtin_amdgcn_global_load_lds((const unsigned*)((const char*)(gbase) + (voff)[_i]), (LAS unsigned*)(lds + (bufoff) + ldsw + _i * 8192), 16, 0, 0); } while (0)
#define PG8_LDA(dst, b, h) do { _Pragma("unroll") for (int m = 0; m < 4; ++m) _Pragma("unroll") for (int k = 0; k < 2; ++k) dst[m][k] = *(const LAS f16x8*)(lds + PG8_SA(b, h) + aoff + m * 2048 + k * 1024); } while (0)
#define PG8_LDB(dst, b, h) do { _Pragma("unroll") for (int n = 0; n < 2; ++n) _Pragma("unroll") for (int k = 0; k < 2; ++k) dst[n][k] = *(const LAS f16x8*)(lds + PG8_SB(b, h) + boff + n * 2048 + k * 1024); } while (0)
#define PG8_MMA(ai, bj, At, Bt) do { __builtin_amdgcn_s_setprio(1); _Pragma("unroll") for (int m = 0; m < 4; ++m) _Pragma("unroll") for (int n = 0; n < 2; ++n) _Pragma("unroll") for (int k = 0; k < 2; ++k) \
        acc[ai][bj][m][n] = __builtin_amdgcn_mfma_f32_16x16x32_f16(Bt[n][k], At[m][k], acc[ai][bj][m][n], 0, 0, 0); __builtin_amdgcn_s_setprio(0); } while (0)
#define PG8_WAIT_V(n) asm volatile("s_waitcnt vmcnt(" #n ")" ::: "memory")
#define PG8_WAIT_L(n) asm volatile("s_waitcnt lgkmcnt(" #n ")" ::: "memory")
#define PG8_BAR __builtin_amdgcn_s_barrier()
#define PG8_SCHED __builtin_amdgcn_sched_barrier(0)
    Unit cur, nxt; int ui = 0;
    if (!S.next(0, cur)) return;
    f32x4 acc[2][2][4][2];
#pragma unroll
    for (int a = 0; a < 2; ++a)
#pragma unroll
        for (int b = 0; b < 2; ++b)
#pragma unroll
            for (int m = 0; m < 4; ++m)
#pragma unroll
                for (int n = 0; n < 2; ++n) acc[a][b][m][n] = (f32x4){0.f, 0.f, 0.f, 0.f};
    f16x8 At[4][2], B0[2][2], B1[2][2];
    const char* cA = cur.A; const char* cB = cur.B;
    PG8_STAGE(PG8_SB(0, 0), cB, voffB); PG8_STAGE(PG8_SB(0, 1), cB + hstepB, voffB); PG8_STAGE(PG8_SA(0, 0), cA, voffA); PG8_STAGE(PG8_SA(0, 1), cA + hstepA, voffA);
    if (wr == 1) PG8_BAR;
    PG8_WAIT_V(2); PG8_BAR;
    PG8_STAGE(PG8_SB(1, 0), cB + kstep, voffB); PG8_STAGE(PG8_SA(1, 0), cA + kstep, voffA); PG8_STAGE(PG8_SB(1, 1), cB + hstepB + kstep, voffB);
    PG8_WAIT_V(6); PG8_BAR;
    for (;;) {
        const bool has_next = S.next(ui + 1, nxt);
        const char* nA = has_next ? nxt.A : cA; const char* nB = has_next ? nxt.B : cB;
#pragma clang loop unroll(disable)
        for (int t = 0; t < nt; t += 2) {
            const bool last = (t == nt - 2);
            const char* a1 = cA + (size_t)(t + 1) * kstep;
            const char* a2 = last ? nA : cA + (size_t)(t + 2) * kstep; const char* b2 = last ? nB : cB + (size_t)(t + 2) * kstep;
            const char* a3 = a2 + kstep; const char* b3 = b2 + kstep;
            PG8_LDB(B0, 0, 0); PG8_LDB(B1, 0, 1); PG8_SCHED; PG8_LDA(At, 0, 0); PG8_STAGE(PG8_SA(1, 1), a1 + hstepA, voffA);
            PG8_WAIT_V(8); PG8_WAIT_L(0); PG8_BAR; PG8_MMA(0, 0, At, B0); PG8_MMA(0, 1, At, B1); PG8_BAR; PG8_SCHED;
            PG8_LDA(At, 0, 1); PG8_STAGE(PG8_SB(0, 0), b2, voffB); PG8_STAGE(PG8_SB(0, 1), b2 + hstepB, voffB); PG8_STAGE(PG8_SA(0, 0), a2, voffA);
            PG8_WAIT_V(8); PG8_WAIT_L(0); PG8_BAR; PG8_MMA(1, 0, At, B0); PG8_MMA(1, 1, At, B1); PG8_BAR; PG8_SCHED;
            PG8_LDB(B0, 1, 0); PG8_LDB(B1, 1, 1); PG8_SCHED; PG8_LDA(At, 1, 0); PG8_STAGE(PG8_SA(0, 1), a2 + hstepA, voffA);
            PG8_WAIT_V(8); PG8_WAIT_L(0); PG8_BAR; PG8_MMA(0, 0, At, B0); PG8_MMA(0, 1, At, B1); PG8_BAR; PG8_SCHED;
            PG8_LDA(At, 1, 1); PG8_STAGE(PG8_SB(1, 0), b3, voffB); PG8_STAGE(PG8_SB(1, 1), b3 + hstepB, voffB); PG8_STAGE(PG8_SA(1, 0), a3, voffA);
            PG8_WAIT_V(8); PG8_WAIT_L(0); PG8_BAR; PG8_MMA(1, 0, At, B0); PG8_MMA(1, 1, At, B1); PG8_BAR; PG8_SCHED;
        }
        if constexpr (ALIGN_EPI) { if (wr == 0) PG8_BAR; }
        if constexpr (!Epi::AFTER_DRAIN) { E(acc, cur, wr, wc, fr, fq); }
        if (!has_next) break;
#pragma unroll
        for (int a = 0; a < 2; ++a)
#pragma unroll
            for (int b = 0; b < 2; ++b)
#pragma unroll
                for (int m = 0; m < 4; ++m)
#pragma unroll
                    for (int n = 0; n < 2; ++n) acc[a][b][m][n] = (f32x4){0.f, 0.f, 0.f, 0.f};
        cur = nxt; cA = nA; cB = nB; ++ui;
        if constexpr (ALIGN_EPI) { if (wr == 1) PG8_BAR; }
    }
    PG8_WAIT_V(0);
    if constexpr (!ALIGN_EPI) { if (wr == 0) PG8_BAR; }
    PG8_BAR;
    if constexpr (Epi::AFTER_DRAIN) { E.fused(acc, cur, wr, wc, fr, fq, lds, wid, lane); }
#undef PG8_SA
#undef PG8_SB
#undef PG8_STAGE
#undef PG8_LDA
#undef PG8_LDB
#undef PG8_MMA
#undef PG8_WAIT_V
#undef PG8_WAIT_L
#undef PG8_BAR
#undef PG8_SCHED
}
}
using pg8::Unit;

struct Args {
    const float* x; const float* mem; const int* pos; const float* w_in; const float* q_norm_g; const float* w_uq; const float* kv_norm_g; const float* w_uk; const float* w_uv;
    const float* conv_w; const float* conv_b; const float* conv_ln_g; const float* conv_ln_b; const float* w_o; const float* ln1_g; const float* ln1_b;
    const float* xa_w_q; const float* xa_w_k; const float* xa_w_v; const float* xa_w_o; const float* ln2_g; const float* ln2_b;
    const float* w_router; const float* w_gate; const float* w_up; const float* w_down; const float* ln3_g; const float* ln3_b;
    float* out; unsigned char* ws;
    float invf[16];
    int ph_lo, ph_hi;
};

struct Frame { LAS unsigned char* lds; int tid, lane, wave, vcu, G; unsigned char* ws; };
__device__ __forceinline__ void frame_ids(Frame& F) { const int t = opaque_tid(); F.tid = t; F.lane = t & 63; F.wave = __builtin_amdgcn_readfirstlane(t >> 6); }

template <int MODE>
__device__ __forceinline__ void tr_item(const float* W, int K, int N, f16* WT, int ldt, int row_off, int col_off, const float* kscale, LAS float* scr, int item, int lane) {
    const int nblk = N / 32, kb = item / nblk, nb = item % nblk, k0 = 64 * kb, n0 = 32 * nb;
#pragma unroll 8
    for (int i = 0; i < 32; ++i) { const int kk = 2 * i + (lane >> 5); float v = W[(size_t)(k0 + kk) * N + n0 + (lane & 31)]; if (kscale) v *= kscale[k0 + kk]; scr[kk * 33 + (lane & 31)] = v; }
    LDS_WAIT(); asm volatile("" ::: "memory");
    const int c = lane & 7;
#pragma unroll
    for (int j = 0; j < 4; ++j) { const int n = (lane >> 3) + 8 * j; const LAS float* s = scr + (8 * c) * 33 + n;
        u32x4 o; o.x = pk_h2(s[0 * 33], s[1 * 33]); o.y = pk_h2(s[2 * 33], s[3 * 33]); o.z = pk_h2(s[4 * 33], s[5 * 33]); o.w = pk_h2(s[6 * 33], s[7 * 33]);
        const int nn = n0 + n; const int drow = (MODE == 0) ? (row_off + nn) : (row_off + 256 * (nn >> 7) + (nn & 127));
        *(GAS u32x4*)(WT + (size_t)drow * ldt + col_off + k0 + 8 * c) = o; }
    LDS_WAIT(); asm volatile("" ::: "memory");
}
__device__ __forceinline__ void cvt_rows(const float* src, f16* dst, size_t n8, int gw, int NGW, int lane) {
    for (size_t i = (size_t)gw * 64 + lane; i < n8; i += (size_t)NGW * 64) {
        const f32x4 a = *(const GAS f32x4*)(src + i * 8), b = *(const GAS f32x4*)(src + i * 8 + 4);
        u32x4 o; o.x = pk_h2(a.x, a.y); o.y = pk_h2(a.z, a.w); o.z = pk_h2(b.x, b.y); o.w = pk_h2(b.z, b.w);
        *(GAS u32x4*)(dst + i * 8) = o; }
}
__device__ __forceinline__ void zero_block(f16* base, int ld, int nrows, int ncols8, int gw, int NGW, int lane) {
    const u32x4 z = {0u, 0u, 0u, 0u};
    for (size_t i = (size_t)gw * 64 + lane; i < (size_t)nrows * ncols8; i += (size_t)NGW * 64) { const size_t r = i / ncols8, c = i % ncols8; *(GAS u32x4*)(base + r * ld + c * 8) = z; }
}
__device__ __forceinline__ void p0_prologue(const Args& a, Frame& F) {
    LAS float* scr = (LAS float*)(F.lds + F.wave * 16384);
    const int gw = F.vcu * NWAVES + F.wave, NGW = F.G * NWAVES, lane = F.lane;
    unsigned char* ws = F.ws;
    f16* WIN = (f16*)(ws + WS_WIN); f16* WUP = (f16*)(ws + WS_WUP); f16* WGU = (f16*)(ws + WS_WGU); f16* WD = (f16*)(ws + WS_WD);
    constexpr int I_IN = 16 * 45, I_UQ = 4 * 24, I_UK = 2 * 16, I_SQ = 16 * 32, I_G = 16 * 64, I_DN = 32 * 32;
    constexpr int NSMALL = I_IN + I_UQ + 2 * I_UK + 5 * I_SQ;
    constexpr int NITEMS = NSMALL + NE * (2 * I_G + I_DN);
    for (int it = gw; it < NITEMS; it += NGW) {
        int r = it;
        if (r < I_IN) { tr_item<0>(a.w_in, 1024, 1440, WIN, 1024, 0, 0, nullptr, scr, r, lane); continue; } r -= I_IN;
        if (r < I_UQ) { tr_item<0>(a.w_uq, 256, 768, WUP, 384, 0, 0, a.q_norm_g, scr, r, lane); continue; } r -= I_UQ;
        if (r < I_UK) { tr_item<0>(a.w_uk, 128, 512, WUP, 384, 768, 256, a.kv_norm_g, scr, r, lane); continue; } r -= I_UK;
        if (r < I_UK) { tr_item<0>(a.w_uv, 128, 512, WUP, 384, 1280, 256, a.kv_norm_g, scr, r, lane); continue; } r -= I_UK;
        if (r < I_SQ) { tr_item<0>(a.w_o, 1024, 1024, (f16*)(ws + WS_WO), 1024, 0, 0, nullptr, scr, r, lane); continue; } r -= I_SQ;
        if (r < I_SQ) { tr_item<0>(a.xa_w_q, 1024, 1024, (f16*)(ws + WS_XWQ), 1024, 0, 0, nullptr, scr, r, lane); continue; } r -= I_SQ;
        if (r < I_SQ) { tr_item<0>(a.xa_w_k, 1024, 1024, (f16*)(ws + WS_XWK), 1024, 0, 0, nullptr, scr, r, lane); continue; } r -= I_SQ;
        if (r < I_SQ) { tr_item<0>(a.xa_w_v, 1024, 1024, (f16*)(ws + WS_XWV), 1024, 0, 0, nullptr, scr, r, lane); continue; } r -= I_SQ;
        if (r < I_SQ) { tr_item<0>(a.xa_w_o, 1024, 1024, (f16*)(ws + WS_XWO), 1024, 0, 0, nullptr, scr, r, lane); continue; } r -= I_SQ;
        const int e = r / (2 * I_G + I_DN); r -= e * (2 * I_G + I_DN);
        if (r < I_G) { tr_item<1>(a.w_gate + (size_t)e * 1024 * 2048, 1024, 2048, WGU + (size_t)e * 4096 * 1024, 1024, 0, 0, nullptr, scr, r, lane); continue; } r -= I_G;
        if (r < I_G) { tr_item<1>(a.w_up + (size_t)e * 1024 * 2048, 1024, 2048, WGU + (size_t)e * 4096 * 1024, 1024, 128, 0, nullptr, scr, r, lane); continue; } r -= I_G;
        tr_item<0>(a.w_down + (size_t)e * 2048 * 1024, 2048, 1024, WD + (size_t)e * 1024 * 2048, 2048, 0, 0, nullptr, scr, r, lane);
    }
    zero_block(WIN + (size_t)1440 * 1024, 1024, 96, 128, gw, NGW, lane);
    zero_block(WUP + 256, 384, 768, 16, gw, NGW, lane);
    zero_block(WUP + (size_t)768 * 384, 384, 1024, 32, gw, NGW, lane);
    cvt_rows(a.x, (f16*)(ws + WS_XH), (size_t)T * D / 8, gw, NGW, lane);
    cvt_rows(a.mem, (f16*)(ws + WS_MEMH), (size_t)MT * D / 8, gw, NGW, lane);
    float* CS = (float*)(ws + WS_CS);
    for (int i = gw * 64 + lane; i < T * 16; i += NGW * 64) {
        const int t = i >> 4, k = i & 15; const float ang = (float)a.pos[t] * a.invf[k];
        const double rev = (double)ang * 0.15915494309189533577; const float fr = (float)(rev - floor(rev));
        *(GAS f32x2*)(CS + (size_t)i * 2) = (f32x2){__builtin_amdgcn_cosf(fr), __builtin_amdgcn_sinf(fr)}; }
}

struct SchedG1 { int vcu, G; const char* XH; const char* WIN; const char* MEMH; const char* XWK; const char* XWV;
    __device__ __forceinline__ bool next(int i, Unit& u) const { const int L = i * G + vcu; if (L >= 448) return false;
        if (L < 384) { u.z = 0; u.pm = L / 6; u.pn = L % 6; u.A = XH + (size_t)u.pm * 256 * 1024 * 2; u.B = WIN + (size_t)u.pn * 256 * 1024 * 2; }
        else { const int j = L - 384;
            if (j < 32) { u.z = 1; u.pm = j >> 2; u.pn = j & 3; u.A = MEMH + (size_t)u.pm * 256 * 1024 * 2; u.B = XWK + (size_t)u.pn * 256 * 1024 * 2; }
            else { const int q = j - 32; u.z = 2; u.pm = q >> 3; u.pn = q & 7; u.A = XWV + (size_t)u.pm * 256 * 1024 * 2; u.B = MEMH + (size_t)u.pn * 256 * 1024 * 2; } }
        return true; } };
struct SchedGrid { int vcu, G, nN, total; const char* A; const char* B; size_t astep, bstep;
    __device__ __forceinline__ bool next(int i, Unit& u) const { const int L = i * G + vcu; if (L >= total) return false;
        u.z = 0; u.pm = L / nN; u.pn = L % nN; u.A = A + (size_t)u.pm * astep; u.B = B + (size_t)u.pn * bstep; return true; } };
struct SchedXS { int vcu, G; const char* A; const char* B; int mode;
    __device__ __forceinline__ bool next(int i, Unit& u) const { const int L = i * G + vcu; if (L >= 256) return false;
        const int b = L >> 5, h = (L >> 3) & 3, qb = L & 7; u.z = b; u.pm = b * 8 + qb; u.pn = h;
        u.A = A + ((size_t)(b * SEQ + qb * 256) * 1024 + h * 256) * 2;
        u.B = (mode == 0) ? B + ((size_t)(b * MEML) * 1024 + h * 256) * 2 : B + ((size_t)(h * 256) * MT + b * MEML) * 2;
        return true; } };
struct SchedMoE { int vcu, G, npn, total; const char* A; const char* B; size_t a_e, b_e, astep, bstep;
    __device__ __forceinline__ bool next(int i, Unit& u) const { const int L = i * G + vcu; if (L >= total) return false;
        const int per = 8 * npn, e = L / per, r = L % per; u.z = e; u.pn = r >> 3; u.pm = r & 7;
        u.A = A + (size_t)e * a_e + (size_t)u.pm * astep; u.B = B + (size_t)e * b_e + (size_t)u.pn * bstep; return true; } };

struct EpiG1 {
    static constexpr bool PERM = true, AFTER_DRAIN = false;
    f16* HCAT; f16* MK; f16* MVT; float* RS;
    __device__ __forceinline__ void operator()(const f32x4 (&acc)[2][2][4][2], const Unit& u, int wr, int wc, int fr, int fq) const {
        f16* base; int ld;
        if (u.z == 0) { base = HCAT + (size_t)(u.pm * 256) * LDH + u.pn * 256; ld = LDH; }
        else if (u.z == 1) { base = MK + (size_t)(u.pm * 256) * 1024 + u.pn * 256; ld = 1024; }
        else { base = MVT + (size_t)(u.pm * 256) * MT + u.pn * 256; ld = MT; }
        const int row0 = wr * 64 + fr, col0 = wc * 32 + 8 * fq;
        const bool stat = (u.z == 0 && u.pn < 2);
#pragma unroll
        for (int ai = 0; ai < 2; ++ai)
#pragma unroll
            for (int m = 0; m < 4; ++m) { const int row = row0 + ai * 128 + m * 16; f16* rowp = base + (size_t)row * ld + col0; float ss[2];
#pragma unroll
                for (int bj = 0; bj < 2; ++bj) { const f32x4 v0 = acc[ai][bj][m][0], v1 = acc[ai][bj][m][1];
                    u32x4 w; w.x = pk_h2(v0[0], v0[1]); w.y = pk_h2(v0[2], v0[3]); w.z = pk_h2(v1[0], v1[1]); w.w = pk_h2(v1[2], v1[3]);
                    *(GAS u32x4*)(rowp + bj * 128) = w;
                    ss[bj] = (v0[0] * v0[0] + v0[1] * v0[1]) + (v0[2] * v0[2] + v0[3] * v0[3]) + (v1[0] * v1[0] + v1[1] * v1[1]) + (v1[2] * v1[2] + v1[3] * v1[3]); }
                if (stat) { float s = (u.pn == 0) ? ss[0] + ss[1] : ss[0]; s += __shfl_xor(s, 16); s += __shfl_xor(s, 32);
                    if (fq == 0) atomicAdd(RS + (size_t)(u.pm * 256 + row) * 2 + u.pn, s); } }
    }
};
struct EpiUP {
    static constexpr bool PERM = false, AFTER_DRAIN = false;
    f16* Q; f16* Kb; f16* V; const float* RS; const float* CS;
    __device__ __forceinline__ void operator()(const f32x4 (&acc)[2][2][4][2], const Unit& u, int wr, int wc, int fr, int fq) const {
        const int pn = u.pn, row0 = u.pm * 256 + wr * 64 + fr;
#pragma unroll
        for (int ai = 0; ai < 2; ++ai)
#pragma unroll
            for (int m = 0; m < 4; ++m) { const int row = row0 + ai * 128 + m * 16;
                const f32x2 rs = *(const GAS f32x2*)(RS + (size_t)row * 2);
                if (pn < 3) { const float sc = __builtin_amdgcn_rsqf(rs.x * (1.0f / 256.0f) + EPS) * QSCALE;
#pragma unroll
                    for (int bj = 0; bj < 2; ++bj) { const int g32 = 8 * pn + 4 * bj + wc; f32x4 x0 = acc[ai][bj][m][0] * sc, x1 = acc[ai][bj][m][1] * sc;
                        if (g32 % 3 == 2) { const f32x4 c01 = *(const GAS f32x4*)(CS + (size_t)row * 32 + fq * 8), c23 = *(const GAS f32x4*)(CS + (size_t)row * 32 + fq * 8 + 4);
                            const f32x4 cs = {c01[0], c01[2], c23[0], c23[2]}, sn = {c01[1], c01[3], c23[1], c23[3]};
                            const f32x4 o0 = x0 * cs - x1 * sn, o1 = x1 * cs + x0 * sn; x0 = o0; x1 = o1; }
                        f16* p = Q + (size_t)row * 768 + g32 * 32 + 4 * fq;
                        *(GAS u32x2*)p = (u32x2){pk_h2(x0[0], x0[1]), pk_h2(x0[2], x0[3])}; *(GAS u32x2*)(p + 16) = (u32x2){pk_h2(x1[0], x1[1]), pk_h2(x1[2], x1[3])}; }
                } else { const float sc = __builtin_amdgcn_rsqf(rs.y * (1.0f / 128.0f) + EPS);
#pragma unroll
                    for (int bj = 0; bj < 2; ++bj)
#pragma unroll
                        for (int n = 0; n < 2; ++n) { const f32x4 x = acc[ai][bj][m][n] * sc; const int c = 256 * ((pn - 3) & 1) + 128 * bj + 32 * wc + 16 * n + 4 * fq;
                            f16* p = (pn < 5) ? Kb + (size_t)row * 768 + (c >> 6) * 96 + (c & 63) : V + (size_t)row * 512 + c;
                            *(GAS u32x2*)p = (u32x2){pk_h2(x[0], x[1]), pk_h2(x[2], x[3])}; }
                }
                asm volatile("" ::: "memory"); }
    }
};
struct EpiPre {
    static constexpr bool PERM = false, AFTER_DRAIN = false;
    const float* R; float* PRE;
    __device__ __forceinline__ void operator()(const f32x4 (&acc)[2][2][4][2], const Unit& u, int wr, int wc, int fr, int fq) const {
        const int row0 = u.pm * 256 + wr * 64 + fr, col0 = u.pn * 256 + wc * 32 + 4 * fq;
#pragma unroll
        for (int ai = 0; ai < 2; ++ai)
#pragma unroll
            for (int m = 0; m < 4; ++m) { const size_t off = (size_t)(row0 + ai * 128 + m * 16) * D + col0;
#pragma unroll
                for (int bj = 0; bj < 2; ++bj)
#pragma unroll
                    for (int n = 0; n < 2; ++n) { const f32x4 r = *(const GAS f32x4*)(R + off + bj * 128 + n * 16); *(GAS f32x4*)(PRE + off + bj * 128 + n * 16) = acc[ai][bj][m][n] + r * ALPHA; } }
    }
};
struct EpiH16 {
    static constexpr bool PERM = true, AFTER_DRAIN = false;
    f16* O; int ld; float scale;
    __device__ __forceinline__ void operator()(const f32x4 (&acc)[2][2][4][2], const Unit& u, int wr, int wc, int fr, int fq) const {
        f16* base = O + (size_t)(u.pm * 256 + wr * 64 + fr) * ld + u.pn * 256 + wc * 32 + 8 * fq;
#pragma unroll
        for (int ai = 0; ai < 2; ++ai)
#pragma unroll
            for (int m = 0; m < 4; ++m) { f16* rowp = base + (size_t)(ai * 128 + m * 16) * ld;
#pragma unroll
                for (int bj = 0; bj < 2; ++bj) { const f32x4 v0 = acc[ai][bj][m][0] * scale, v1 = acc[ai][bj][m][1] * scale;
                    u32x4 w; w.x = pk_h2(v0[0], v0[1]); w.y = pk_h2(v0[2], v0[3]); w.z = pk_h2(v1[0], v1[1]); w.w = pk_h2(v1[2], v1[3]);
                    *(GAS u32x4*)(rowp + bj * 128) = w; } }
    }
};
struct EpiSoftmax {
    static constexpr bool PERM = true, AFTER_DRAIN = true;
    f16* P;
    __device__ __forceinline__ void fused(f32x4 (&acc)[2][2][4][2], const Unit& u, int wr, int wc, int fr, int fq, LAS unsigned char* lds, int wid, int lane) const {
        LAS float* RM = (LAS float*)lds; LAS float* RSM = (LAS float*)(lds + 4096);
#pragma unroll
        for (int ai = 0; ai < 2; ++ai)
#pragma unroll
            for (int m = 0; m < 4; ++m) { float v = -3.0e38f;
#pragma unroll
                for (int bj = 0; bj < 2; ++bj)
#pragma unroll
                    for (int n = 0; n < 2; ++n) { const f32x4 x = acc[ai][bj][m][n]; v = fmaxf(v, fmaxf(fmaxf(x[0], x[1]), fmaxf(x[2], x[3]))); }
                v = fmaxf(v, __shfl_xor(v, 16)); v = fmaxf(v, __shfl_xor(v, 32));
                if (fq == 0) RM[(ai * 128 + wr * 64 + m * 16 + fr) * 4 + wc] = v; }
        asm volatile("s_waitcnt lgkmcnt(0)" ::: "memory"); __builtin_amdgcn_s_barrier(); asm volatile("" ::: "memory");
#pragma unroll
        for (int ai = 0; ai < 2; ++ai)
#pragma unroll
            for (int m = 0; m < 4; ++m) { const f32x4 r = *(const LAS f32x4*)(RM + (ai * 128 + wr * 64 + m * 16 + fr) * 4); const float mx = fmaxf(fmaxf(r[0], r[1]), fmaxf(r[2], r[3])); float s = 0.f;
#pragma unroll
                for (int bj = 0; bj < 2; ++bj)
#pragma unroll
                    for (int n = 0; n < 2; ++n) { f32x4 x = acc[ai][bj][m][n];
#pragma unroll
                        for (int j = 0; j < 4; ++j) { x[j] = __builtin_amdgcn_exp2f(x[j] - mx); s += x[j]; }
                        acc[ai][bj][m][n] = x; }
                s += __shfl_xor(s, 16); s += __shfl_xor(s, 32);
                if (fq == 0) RSM[(ai * 128 + wr * 64 + m * 16 + fr) * 4 + wc] = s;
                asm volatile("" ::: "memory"); }
        asm volatile("s_waitcnt lgkmcnt(0)" ::: "memory"); __builtin_amdgcn_s_barrier(); asm volatile("" ::: "memory");
        f16* base = P + (size_t)(u.pm * 256 + wr * 64 + fr) * 1024 + u.pn * 256 + wc * 32 + 8 * fq;
#pragma unroll
        for (int ai = 0; ai < 2; ++ai)
#pragma unroll
            for (int m = 0; m < 4; ++m) { const f32x4 r = *(const LAS f32x4*)(RSM + (ai * 128 + wr * 64 + m * 16 + fr) * 4); const float inv = 1.0f / ((r[0] + r[1]) + (r[2] + r[3]));
                f16* rowp = base + (size_t)(ai * 128 + m * 16) * 1024;
#pragma unroll
                for (int bj = 0; bj < 2; ++bj) { const f32x4 v0 = acc[ai][bj][m][0] * inv, v1 = acc[ai][bj][m][1] * inv;
                    u32x4 w; w.x = pk_h2(v0[0], v0[1]); w.y = pk_h2(v0[2], v0[3]); w.z = pk_h2(v1[0], v1[1]); w.w = pk_h2(v1[2], v1[3]);
                    *(GAS u32x4*)(rowp + bj * 128) = w; }
                asm volatile("" ::: "memory"); }
    }
};
struct EpiHid {
    static constexpr bool PERM = true, AFTER_DRAIN = false;
    f16* HID;
    __device__ __forceinline__ void operator()(const f32x4 (&acc)[2][2][4][2], const Unit& u, int wr, int wc, int fr, int fq) const {
        f16* base = HID + (size_t)(u.z * 2048 + u.pm * 256 + wr * 64 + fr) * FF + u.pn * 128 + wc * 32 + 8 * fq;
#pragma unroll
        for (int ai = 0; ai < 2; ++ai)
#pragma unroll
            for (int m = 0; m < 4; ++m) { f32x4 h[2];
#pragma unroll
                for (int n = 0; n < 2; ++n) { const f32x4 g = acc[ai][0][m][n], up = acc[ai][1][m][n];
#pragma unroll
                    for (int j = 0; j < 4; ++j) h[n][j] = g[j] * __builtin_amdgcn_rcpf(1.0f + __builtin_amdgcn_exp2f(-g[j] * LOG2E)) * up[j]; }
                u32x4 w; w.x = pk_h2(h[0][0], h[0][1]); w.y = pk_h2(h[0][2], h[0][3]); w.z = pk_h2(h[1][0], h[1][1]); w.w = pk_h2(h[1][2], h[1][3]);
                *(GAS u32x4*)(base + (size_t)(ai * 128 + m * 16) * FF) = w; }
    }
};
struct EpiY {
    static constexpr bool PERM = true, AFTER_DRAIN = false;
    f16* Y; const float* GATE;
    __device__ __forceinline__ void operator()(const f32x4 (&acc)[2][2][4][2], const Unit& u, int wr, int wc, int fr, int fq) const {
        const int r0 = wr * 64 + fr; const float* gp = GATE + (size_t)(u.pm * NE + u.z) * CAP;
        f16* base = Y + (size_t)(u.z * 2048 + u.pm * 256 + r0) * D + u.pn * 256 + wc * 32 + 8 * fq;
#pragma unroll
        for (int ai = 0; ai < 2; ++ai)
#pragma unroll
            for (int m = 0; m < 4; ++m) { const float gt = gp[r0 + ai * 128 + m * 16]; f16* rowp = base + (size_t)(ai * 128 + m * 16) * D;
#pragma unroll
                for (int bj = 0; bj < 2; ++bj) { const f32x4 v0 = acc[ai][bj][m][0] * gt, v1 = acc[ai][bj][m][1] * gt;
                    u32x4 w; w.x = pk_h2(v0[0], v0[1]); w.y = pk_h2(v0[2], v0[3]); w.z = pk_h2(v1[0], v1[1]); w.w = pk_h2(v1[2], v1[3]);
                    *(GAS u32x4*)(rowp + bj * 128) = w; } }
    }
};

__device__ __forceinline__ void krope_pass(Frame& F) {
    const f16* HC = (const f16*)(F.ws + WS_HCAT); f16* Kb = (f16*)(F.ws + WS_K); const float* CS = (const float*)(F.ws + WS_CS);
    for (int i = (F.vcu * NTHR + F.tid); i < T * 16; i += F.G * NTHR) { const int t = i >> 4, k = i & 15;
        const float x1 = (float)HC[(size_t)t * LDH + 384 + k], x2 = (float)HC[(size_t)t * LDH + 400 + k]; const f32x2 cs = *(const GAS f32x2*)(CS + (size_t)i * 2);
        const f16 o1 = (f16)(x1 * cs.x - x2 * cs.y), o2 = (f16)(x2 * cs.x + x1 * cs.y);
#pragma unroll
        for (int h = 0; h < 8; ++h) { Kb[(size_t)t * 768 + h * 96 + 64 + k] = o1; Kb[(size_t)t * 768 + h * 96 + 80 + k] = o2; } }
}
__device__ __forceinline__ void conv_phase(const Args& a, Frame& F) {
    LAS f16* GL = (LAS f16*)F.lds;
    LAS float* CO = (LAS float*)(F.lds + 62 * 512 * 2);
    const f16* HC = (const f16*)(F.ws + WS_HCAT); f16* AO = (f16*)(F.ws + WS_AO);
    const int tid = F.tid, lane = F.lane, wave = F.wave;
    float w[CW];
#pragma unroll
    for (int j = 0; j < CW; ++j) w[j] = a.conv_w[j * CCH + tid];
    const float cb = a.conv_b[tid];
    for (int tile = F.vcu; tile < T / 32; tile += F.G) {
        const int t0 = tile * 32, s0 = t0 % SEQ;
        for (int i = tid; i < 62 * 64; i += NTHR) { const int r = i >> 6, c8 = (i & 63) * 8; const int s = s0 - CPAD + r;
            u32x4 o = {0u, 0u, 0u, 0u};
            if (s >= 0 && s < SEQ) { const f16* hp = HC + (size_t)(t0 - CPAD + r) * LDH + 416 + c8;
                const f16x8 av = *(const GAS f16x8*)hp, gv = *(const GAS f16x8*)(hp + 512); float y[8];
#pragma unroll
                for (int j = 0; j < 8; ++j) { const float g = (float)gv[j]; y[j] = (float)av[j] * __builtin_amdgcn_rcpf(1.0f + __builtin_amdgcn_exp2f(-g * LOG2E)); }
                o.x = pk_h2(y[0], y[1]); o.y = pk_h2(y[2], y[3]); o.z = pk_h2(y[4], y[5]); o.w = pk_h2(y[6], y[7]); }
            *(LAS u32x4*)(GL + r * 512 + c8) = o; }
        __syncthreads();
        for (int s = 0; s < 32; ++s) { float acc = cb;
#pragma unroll
            for (int j = 0; j < CW; ++j) acc += w[j] * (float)GL[(s + j) * 512 + tid];
            CO[s * 512 + tid] = acc; }
        __syncthreads();
#pragma unroll
        for (int q = 0; q < 4; ++q) { const int s = wave * 4 + q; const LAS float* cp = CO + s * 512 + lane * 8;
            const f32x4 v0 = *(const LAS f32x4*)cp, v1 = *(const LAS f32x4*)(cp + 4);
            const float mean = wave_sum((v0[0] + v0[1]) + (v0[2] + v0[3]) + (v1[0] + v1[1]) + (v1[2] + v1[3])) * (1.0f / CCH);
            const f32x4 d0 = v0 - mean, d1 = v1 - mean;
            const float var = wave_sum((d0[0] * d0[0] + d0[1] * d0[1]) + (d0[2] * d0[2] + d0[3] * d0[3]) + (d1[0] * d1[0] + d1[1] * d1[1]) + (d1[2] * d1[2] + d1[3] * d1[3])) * (1.0f / CCH);
            const float rstd = __builtin_amdgcn_rsqf(var + EPS);
            const f32x4 g0 = *(const GAS f32x4*)(a.conv_ln_g + lane * 8), g1 = *(const GAS f32x4*)(a.conv_ln_g + lane * 8 + 4);
            const f32x4 b0 = *(const GAS f32x4*)(a.conv_ln_b + lane * 8), b1 = *(const GAS f32x4*)(a.conv_ln_b + lane * 8 + 4);
            f32x4 y0 = d0 * rstd * g0 + b0, y1 = d1 * rstd * g1 + b1;
#pragma unroll
            for (int j = 0; j < 4; ++j) { y0[j] = y0[j] * __builtin_amdgcn_rcpf(1.0f + __builtin_amdgcn_exp2f(-y0[j] * LOG2E)); y1[j] = y1[j] * __builtin_amdgcn_rcpf(1.0f + __builtin_amdgcn_exp2f(-y1[j] * LOG2E)); }
            u32x4 o; o.x = pk_h2(y0[0], y0[1]); o.y = pk_h2(y0[2], y0[3]); o.z = pk_h2(y1[0], y1[1]); o.w = pk_h2(y1[2], y1[3]);
            *(GAS u32x4*)(AO + (size_t)(t0 + s) * D + 512 + lane * 8) = o; }
        __syncthreads();
    }
}

namespace attn {
constexpr int KP = 208;
constexpr int SHM_K = 64 * KP, SHM_V = 64 * 64 * 2;
constexpr int LDS_V0 = 0, LDS_K0 = 2 * SHM_V, LDS_WS = 2 * SHM_V + 2 * SHM_K;
__device__ __forceinline__ int crow(int r, int hi) { return (r & 3) + 8 * (r >> 2) + 4 * hi; }
#define SBAR() __builtin_amdgcn_sched_barrier(0)
constexpr float THR = 8.0f * LOG2E;
__device__ __forceinline__ void partialSM(f32x16& p0, f32x16& p1, float& m_reg, float& mn, float& alpha) {
    float pmax = p0[0];
#pragma unroll
    for (int r = 1; r < 16; ++r) pmax = fmaxf(pmax, p0[r]);
#pragma unroll
    for (int r = 0; r < 16; ++r) pmax = fmaxf(pmax, p1[r]);
    { auto rr = __builtin_amdgcn_permlane32_swap(__float_as_uint(pmax), __float_as_uint(pmax), false, false); pmax = fmaxf(__uint_as_float(rr[0]), __uint_as_float(rr[1])); }
    if (__builtin_expect(__all(pmax - m_reg <= THR), 1)) { mn = m_reg; alpha = 1.f; }
    else { mn = fmaxf(m_reg, pmax); alpha = __builtin_amdgcn_exp2f(m_reg - mn); m_reg = mn; }
#pragma unroll
    for (int r = 0; r < 16; ++r) { p0[r] = p0[r] - mn; p1[r] = p1[r] - mn; }
#pragma unroll
    for (int r = 0; r < 16; ++r) p0[r] = __builtin_amdgcn_exp2f(p0[r]);
}
__device__ __forceinline__ void finishSM(f32x16& p0, f32x16& p1, float alpha, float& l_reg, f16x8& pa0, f16x8& pa1, f16x8& pa2, f16x8& pa3) {
#pragma unroll
    for (int r = 0; r < 16; ++r) p1[r] = __builtin_amdgcn_exp2f(p1[r]);
    float ps = 0;
#pragma unroll
    for (int r = 0; r < 16; ++r) ps += p0[r];
#pragma unroll
    for (int r = 0; r < 16; ++r) ps += p1[r];
    { auto rr = __builtin_amdgcn_permlane32_swap(__float_as_uint(ps), __float_as_uint(ps), false, false); ps = __uint_as_float(rr[0]) + __uint_as_float(rr[1]); }
    l_reg = l_reg * alpha + ps;
#define PK4(P, BASE, OUT) do { unsigned a0 = pk_h2(P[BASE + 0], P[BASE + 1]), a1 = pk_h2(P[BASE + 2], P[BASE + 3]);   \
    unsigned b0 = pk_h2(P[BASE + 4], P[BASE + 5]), b1 = pk_h2(P[BASE + 6], P[BASE + 7]);                              \
    auto r0 = __builtin_amdgcn_permlane32_swap(a0, b0, false, false); auto r1 = __builtin_amdgcn_permlane32_swap(a1, b1, false, false); \
    u32x4 w = {r0[0], r1[0], r0[1], r1[1]}; OUT = __builtin_bit_cast(f16x8, w); } while (0)
    PK4(p0, 0, pa0); PK4(p0, 8, pa1); PK4(p1, 0, pa2); PK4(p1, 8, pa3);
#undef PK4
}
__device__ __forceinline__ void qkt(f32x16& p0, f32x16& p1, const LAS char* Ks, const f16x8* qr, int r32, int hi) {
    p0 = f32x16{}; p1 = f32x16{};
#pragma unroll
    for (int d0 = 0; d0 < 6; ++d0) { const int cb = d0 * 32 + hi * 16;
        const f16x8 b0 = *(const LAS f16x8*)(Ks + r32 * KP + cb);
        const f16x8 b1 = *(const LAS f16x8*)(Ks + (32 + r32) * KP + cb);
        p0 = __builtin_amdgcn_mfma_f32_32x32x16_f16(b0, qr[d0], p0, 0, 0, 0);
        p1 = __builtin_amdgcn_mfma_f32_32x32x16_f16(b1, qr[d0], p1, 0, 0, 0); }
}
__device__ __forceinline__ int v_st(int k, int c) { const int kk = (k & ~0xC) | ((k & 4) << 1) | ((k & 8) >> 1); return ((kk >> 3) * 2 + (c >> 5)) * 512 + ((kk & 7) * 32 + (c & 31)) * 2; }
__device__ __forceinline__ int v_rd_base(int lane) { return ((lane & 3) << 3) | (((lane >> 2) & 3) << 6) | (((lane >> 4) & 1) << 5) | (((lane >> 5) & 1) << 8); }
constexpr int v_rd_off(int d0, int ks, int half) { return d0 * 512 + ks * 2048 + half * 1024; }
template <int OFF> __device__ __forceinline__ s16x4 tr_read(int vb) { s16x4 r; asm volatile("ds_read_b64_tr_b16 %0, %1 offset:%2" : "=&v"(r) : "v"(vb), "i"(OFF) : "memory"); return r; }
template <int D0> __device__ __forceinline__ void pv_one(f32x16& od, int vb, f16x8 pa0, f16x8 pa1, f16x8 pa2, f16x8 pa3) {
    const s16x4 l0 = tr_read<v_rd_off(D0, 0, 0)>(vb), h0 = tr_read<v_rd_off(D0, 0, 1)>(vb), l1 = tr_read<v_rd_off(D0, 1, 0)>(vb), h1 = tr_read<v_rd_off(D0, 1, 1)>(vb);
    const s16x4 l2 = tr_read<v_rd_off(D0, 2, 0)>(vb), h2 = tr_read<v_rd_off(D0, 2, 1)>(vb), l3 = tr_read<v_rd_off(D0, 3, 0)>(vb), h3 = tr_read<v_rd_off(D0, 3, 1)>(vb);
    asm volatile("s_waitcnt lgkmcnt(0)" ::: "memory"); SBAR();
#define PKV(L, H) __builtin_bit_cast(f16x8, (u32x4){__builtin_bit_cast(u32x2, L)[0], __builtin_bit_cast(u32x2, L)[1], __builtin_bit_cast(u32x2, H)[0], __builtin_bit_cast(u32x2, H)[1]})
    od = __builtin_amdgcn_mfma_f32_32x32x16_f16(pa0, PKV(l0, h0), od, 0, 0, 0);
    od = __builtin_amdgcn_mfma_f32_32x32x16_f16(pa1, PKV(l1, h1), od, 0, 0, 0);
    od = __builtin_amdgcn_mfma_f32_32x32x16_f16(pa2, PKV(l2, h2), od, 0, 0, 0);
    od = __builtin_amdgcn_mfma_f32_32x32x16_f16(pa3, PKV(l3, h3), od, 0, 0, 0);
#undef PKV
}
__device__ __forceinline__ void unit(const f16* __restrict__ Qb, const f16* __restrict__ Kh, const f16* __restrict__ Vh, f16* __restrict__ Ob, LAS char* lds) {
    const int tid = opaque_tid(), wid = __builtin_amdgcn_readfirstlane(tid >> 6), lane = tid & 63, r32 = lane & 31, hi = lane >> 5;
    LAS char* V_lds = lds + LDS_V0; LAS char* K_lds = lds + LDS_K0;
    LAS float* ws = (LAS float*)(lds + LDS_WS) + wid * 64; LAS float* li_l = ws; LAS float* al_l = ws + 32;
    float m_reg = -1e30f, l_reg = 0; f32x16 o[2] = {}; f16x8 qr[6];
    const f16* Qw = Qb + (size_t)(wid * 32 + r32) * 768 + hi * 8;
#pragma unroll
    for (int d0 = 0; d0 < 6; ++d0) qr[d0] = *(const GAS f16x8*)(Qw + d0 * 16);
    const int vr = tid >> 3, vc = (tid & 7) * 8, vst = v_st(vr, vc);
    const int kr0 = tid / 12, kc0 = tid % 12, kr1 = (512 + tid) / 12, kc1 = (512 + tid) % 12; const bool k2 = tid < 256;
    const int kst0 = kr0 * KP + kc0 * 16, kst1 = kr1 * KP + kc1 * 16;
    const int vb0 = (int)(uintptr_t)V_lds + v_rd_base(lane);
    struct { f16x8 vs, ks0, ks1; } sr_[2];
#define SLOAD(i, k0) do { sr_[i].vs = *(const GAS f16x8*)(Vh + (size_t)((k0) + vr) * 512 + vc); sr_[i].ks0 = *(const GAS f16x8*)(Kh + (size_t)((k0) + kr0) * 768 + kc0 * 8); \
    if (k2) sr_[i].ks1 = *(const GAS f16x8*)(Kh + (size_t)((k0) + kr1) * 768 + kc1 * 8); } while (0)
#define SWRITE(b, i) do { *(LAS f16x8*)(V_lds + (b) * SHM_V + vst) = sr_[i].vs; *(LAS f16x8*)(K_lds + (b) * SHM_K + kst0) = sr_[i].ks0; \
    if (k2) *(LAS f16x8*)(K_lds + (b) * SHM_K + kst1) = sr_[i].ks1; } while (0)
#define RESC(a) do { if (__any((a) < 1.f)) { if (hi == 0) al_l[r32] = (a); asm volatile("s_waitcnt lgkmcnt(0)" ::: "memory"); \
    _Pragma("unroll") for (int d = 0; d < 2; ++d) _Pragma("unroll") for (int r = 0; r < 16; ++r) o[d][r] *= al_l[crow(r, hi)]; } } while (0)
    f32x16 pA0, pA1, pB0, pB1; float mnA, mnB, alA, alB; f16x8 pa0, pa1, pa2, pa3; constexpr int NT = SEQ / 64;
    SLOAD(0, 0); asm volatile("s_waitcnt vmcnt(0)" ::: "memory"); SWRITE(0, 0); __syncthreads();
    qkt(pA0, pA1, K_lds, qr, r32, hi); partialSM(pA0, pA1, m_reg, mnA, alA);
    SLOAD(1, 64); SLOAD(0, 128);
    asm volatile("s_waitcnt vmcnt(3)" ::: "memory"); SWRITE(1, 1); __syncthreads();
    for (int j = 1; j + 1 < NT; j += 2) {
        SBAR(); qkt(pB0, pB1, K_lds + SHM_K, qr, r32, hi);
        finishSM(pA0, pA1, alA, l_reg, pa0, pa1, pa2, pa3); SBAR();
        SLOAD(1, (j + 2) * 64); SBAR();
        pv_one<0>(o[0], vb0, pa0, pa1, pa2, pa3); pv_one<1>(o[1], vb0, pa0, pa1, pa2, pa3); partialSM(pB0, pB1, m_reg, mnB, alB);
        __syncthreads(); asm volatile("s_waitcnt vmcnt(3)" ::: "memory"); SWRITE(0, 0);
        RESC(alB); __syncthreads();
        SBAR(); qkt(pA0, pA1, K_lds, qr, r32, hi);
        finishSM(pB0, pB1, alB, l_reg, pa0, pa1, pa2, pa3); SBAR();
        if (j + 3 < NT) SLOAD(0, (j + 3) * 64); SBAR();
        pv_one<0>(o[0], vb0 + SHM_V, pa0, pa1, pa2, pa3); pv_one<1>(o[1], vb0 + SHM_V, pa0, pa1, pa2, pa3); partialSM(pA0, pA1, m_reg, mnA, alA);
        __syncthreads(); asm volatile("s_waitcnt vmcnt(3)" ::: "memory"); SWRITE(1, 1);
        RESC(alA); __syncthreads();
    }
    SBAR(); qkt(pB0, pB1, K_lds + SHM_K, qr, r32, hi);
    finishSM(pA0, pA1, alA, l_reg, pa0, pa1, pa2, pa3); SBAR();
    pv_one<0>(o[0], vb0, pa0, pa1, pa2, pa3); pv_one<1>(o[1], vb0, pa0, pa1, pa2, pa3); partialSM(pB0, pB1, m_reg, mnB, alB);
    __syncthreads(); RESC(alB);
    finishSM(pB0, pB1, alB, l_reg, pa0, pa1, pa2, pa3); SBAR();
    pv_one<0>(o[0], vb0 + SHM_V, pa0, pa1, pa2, pa3); pv_one<1>(o[1], vb0 + SHM_V, pa0, pa1, pa2, pa3);
    if (hi == 0) li_l[r32] = l_reg; asm volatile("s_waitcnt lgkmcnt(0)" ::: "memory");
    float rli[16];
#pragma unroll
    for (int r = 0; r < 16; ++r) rli[r] = __builtin_amdgcn_rcpf(li_l[crow(r, hi)]);
    f16* Ow = Ob + (size_t)(wid * 32) * 1024;
#pragma unroll
    for (int r = 0; r < 16; ++r) { const int orow = crow(r, hi);
#pragma unroll
        for (int d0 = 0; d0 < 2; ++d0) Ow[(size_t)orow * 1024 + d0 * 32 + r32] = (f16)(o[d0][r] * rli[r]); }
    __syncthreads();
#undef SLOAD
#undef SWRITE
#undef RESC
}
__device__ __forceinline__ void unit_naive(const f16* Qb, const f16* Kh, const f16* Vh, f16* Ob) {
    const int tid = opaque_tid(); if (tid >= 256) return;
    float q[96], o[64], m = -1e30f, l = 0.f;
#pragma unroll
    for (int d = 0; d < 96; ++d) q[d] = (float)Qb[(size_t)tid * 768 + d];
#pragma unroll
    for (int d = 0; d < 64; ++d) o[d] = 0.f;
    for (int k = 0; k < SEQ; ++k) { float s = 0.f;
#pragma unroll
        for (int d = 0; d < 96; ++d) s += q[d] * (float)Kh[(size_t)k * 768 + d];
        const float mn = fmaxf(m, s), al = __builtin_amdgcn_exp2f(m - mn), p = __builtin_amdgcn_exp2f(s - mn); m = mn; l = l * al + p;
#pragma unroll
        for (int d = 0; d < 64; ++d) o[d] = o[d] * al + p * (float)Vh[(size_t)k * 512 + d]; }
    const float inv = 1.0f / l;
#pragma unroll
    for (int d = 0; d < 64; ++d) Ob[(size_t)tid * 1024 + d] = (f16)(o[d] * inv);
}
#undef SBAR
}

__device__ __forceinline__ void attn_phase(Frame& F) {
    const f16* Q = (const f16*)(F.ws + WS_Q); const f16* Kb = (const f16*)(F.ws + WS_K); const f16* V = (const f16*)(F.ws + WS_V); f16* AO = (f16*)(F.ws + WS_AO);
    for (int L = F.vcu; L < NB * 8 * 8; L += F.G) { const int bh = L >> 3, qb = L & 7, b = bh >> 3, h = bh & 7;
        const size_t r0 = (size_t)b * SEQ;
#if NAIVE_ATTN
        attn::unit_naive(Q + (r0 + qb * 256) * 768 + h * 96, Kb + r0 * 768 + h * 96, V + r0 * 512 + h * 64, AO + (r0 + qb * 256) * 1024 + h * 64);
#else
        attn::unit(Q + (r0 + qb * 256) * 768 + h * 96, Kb + r0 * 768 + h * 96, V + r0 * 512 + h * 64, AO + (r0 + qb * 256) * 1024 + h * 64, (LAS char*)F.lds);
#endif
    }
}

__device__ __forceinline__ void ln_rows(Frame& F, const float* PRE, const float* g, const float* b, float* H, f16* HH) {
    const int gw = F.vcu * NWAVES + F.wave, NGW = F.G * NWAVES, lane = F.lane;
    f32x4 gv[4], bv[4];
#pragma unroll
    for (int j = 0; j < 4; ++j) { gv[j] = *(const GAS f32x4*)(g + 4 * lane + 256 * j); bv[j] = *(const GAS f32x4*)(b + 4 * lane + 256 * j); }
    for (int row = gw; row < T; row += NGW) { const float* pr = PRE + (size_t)row * D + 4 * lane; f32x4 v[4]; float s = 0.f;
#pragma unroll
        for (int j = 0; j < 4; ++j) { v[j] = *(const GAS f32x4*)(pr + 256 * j); s += (v[j][0] + v[j][1]) + (v[j][2] + v[j][3]); }
        const float mean = wave_sum(s) * (1.0f / D); float s2 = 0.f;
#pragma unroll
        for (int j = 0; j < 4; ++j) { v[j] = v[j] - mean; s2 += (v[j][0] * v[j][0] + v[j][1] * v[j][1]) + (v[j][2] * v[j][2] + v[j][3] * v[j][3]); }
        const float rstd = __builtin_amdgcn_rsqf(wave_sum(s2) * (1.0f / D) + EPS);
#pragma unroll
        for (int j = 0; j < 4; ++j) { const f32x4 y = v[j] * rstd * gv[j] + bv[j];
            *(GAS f32x4*)(H + (size_t)row * D + 4 * lane + 256 * j) = y;
            *(GAS u32x2*)(HH + (size_t)row * D + 4 * lane + 256 * j) = (u32x2){pk_h2(y[0], y[1]), pk_h2(y[2], y[3])}; } }
}
__device__ __forceinline__ void ln2_router(const Args& a, Frame& F) {
    const float* PRE = (const float*)(F.ws + WS_PRE); float* H = (float*)(F.ws + WS_HA); f16* HH = (f16*)(F.ws + WS_HH); float* AFF = (float*)(F.ws + WS_AFF);
    const int gw = F.vcu * NWAVES + F.wave, NGW = F.G * NWAVES, lane = F.lane;
    for (int r0 = gw * 2; r0 < T; r0 += NGW * 2) {
        f32x4 y[2][4];
#pragma unroll
        for (int q = 0; q < 2; ++q) { const float* pr = PRE + (size_t)(r0 + q) * D + 4 * lane; float s = 0.f;
#pragma unroll
            for (int j = 0; j < 4; ++j) { y[q][j] = *(const GAS f32x4*)(pr + 256 * j); s += (y[q][j][0] + y[q][j][1]) + (y[q][j][2] + y[q][j][3]); }
            const float mean = wave_sum(s) * (1.0f / D); float s2 = 0.f;
#pragma unroll
            for (int j = 0; j < 4; ++j) { y[q][j] = y[q][j] - mean; s2 += (y[q][j][0] * y[q][j][0] + y[q][j][1] * y[q][j][1]) + (y[q][j][2] * y[q][j][2] + y[q][j][3] * y[q][j][3]); }
            const float rstd = __builtin_amdgcn_rsqf(wave_sum(s2) * (1.0f / D) + EPS);
#pragma unroll
            for (int j = 0; j < 4; ++j) { const f32x4 gv = *(const GAS f32x4*)(a.ln2_g + 4 * lane + 256 * j), bv = *(const GAS f32x4*)(a.ln2_b + 4 * lane + 256 * j);
                y[q][j] = y[q][j] * rstd * gv + bv;
                *(GAS f32x4*)(H + (size_t)(r0 + q) * D + 4 * lane + 256 * j) = y[q][j];
                *(GAS u32x2*)(HH + (size_t)(r0 + q) * D + 4 * lane + 256 * j) = (u32x2){pk_h2(y[q][j][0], y[q][j][1]), pk_h2(y[q][j][2], y[q][j][3])}; } }
        float part[32];
#pragma unroll
        for (int k = 0; k < 32; ++k) part[k] = 0.f;
        const float* wrow = a.w_router + (size_t)(4 * lane) * NE;
#pragma unroll
        for (int j = 0; j < 4; ++j) { asm volatile("" : "+v"(wrow));
#pragma unroll
            for (int cc = 0; cc < 4; ++cc) { const float* wp = wrow + cc * NE;
                const f32x4 w0 = *(const GAS f32x4*)wp, w1 = *(const GAS f32x4*)(wp + 4), w2 = *(const GAS f32x4*)(wp + 8), w3 = *(const GAS f32x4*)(wp + 12);
#pragma unroll
                for (int q = 0; q < 2; ++q) { const float hv = y[q][j][cc];
#pragma unroll
                    for (int e = 0; e < 4; ++e) { part[q * 16 + e] += hv * w0[e]; part[q * 16 + 4 + e] += hv * w1[e]; part[q * 16 + 8 + e] += hv * w2[e]; part[q * 16 + 12 + e] += hv * w3[e]; } } }
            wrow += 256 * NE; asm volatile("" ::: "memory"); }
#define RSTEP(N, BIT) _Pragma("unroll") for (int k = 0; k < N; ++k) { const bool up = (lane >> BIT) & 1; const float send = up ? part[k] : part[k + N], keep = up ? part[k + N] : part[k]; part[k] = keep + __shfl_xor(send, 1 << BIT); }
        RSTEP(16, 4) RSTEP(8, 3) RSTEP(4, 2) RSTEP(2, 1) RSTEP(1, 0)
#undef RSTEP
        float lg = part[0] + __shfl_xor(part[0], 32), mx = lg;
#pragma unroll
        for (int o = 1; o < 16; o <<= 1) mx = fmaxf(mx, __shfl_xor(mx, o));
        const float p = __builtin_amdgcn_exp2f((lg - mx) * LOG2E); float sm = p;
#pragma unroll
        for (int o = 1; o < 16; o <<= 1) sm += __shfl_xor(sm, o);
        if (lane < 32) AFF[(size_t)r0 * NE + lane] = p / sm;
    }
}
__device__ __forceinline__ void topk_phase(Frame& F) {
    LAS float* vals = (LAS float*)F.lds; LAS int* lst = (LAS int*)(F.lds + 8192);
    const float* AFF = (const float*)(F.ws + WS_AFF); int* TOK = (int*)(F.ws + WS_TOK); float* GATE = (float*)(F.ws + WS_GATE); int* SLOT = (int*)(F.ws + WS_SLOT);
    const f16* HH = (const f16*)(F.ws + WS_HH); f16* XS = (f16*)(F.ws + WS_XS);
    const int tid = F.tid;
    for (int item = F.vcu; item < NB * NE * 2; item += F.G) { const int half = item & 1, e = (item >> 1) & 15, b = item >> 5;
        for (int i = tid; i < SEQ; i += NTHR) vals[i] = AFF[(size_t)(b * SEQ + i) * NE + e];
        if (tid < CAP) lst[tid] = -1;
        __syncthreads();
        const int i0 = half * 1024 + tid, i1 = i0 + 512; const float v0 = vals[i0], v1 = vals[i1]; int r0 = 0, r1 = 0;
        for (int j = 0; j < SEQ; j += 4) { const f32x4 w = *(const LAS f32x4*)(vals + j);
#pragma unroll
            for (int k = 0; k < 4; ++k) { r0 += (w[k] > v0 || (w[k] == v0 && j + k < i0)) ? 1 : 0; r1 += (w[k] > v1 || (w[k] == v1 && j + k < i1)) ? 1 : 0; } }
        const size_t be = (size_t)(b * NE + e) * CAP;
        SLOT[(size_t)(b * SEQ + i0) * NE + e] = (r0 < CAP) ? r0 : -1; SLOT[(size_t)(b * SEQ + i1) * NE + e] = (r1 < CAP) ? r1 : -1;
        if (r0 < CAP) { TOK[be + r0] = i0; GATE[be + r0] = v0; lst[r0] = i0; }
        if (r1 < CAP) { TOK[be + r1] = i1; GATE[be + r1] = v1; lst[r1] = i1; }
        __syncthreads();
        for (int r = F.wave; r < CAP; r += NWAVES) { const int tk = lst[r]; if (tk < 0) continue;
            const f16* src = HH + (size_t)(b * SEQ + tk) * D; f16* dst = XS + ((size_t)e * 2048 + b * CAP + r) * D;
            const u32x4 p0 = *(const GAS u32x4*)(src + F.lane * 8), p1 = *(const GAS u32x4*)(src + 512 + F.lane * 8);
            *(GAS u32x4*)(dst + F.lane * 8) = p0; *(GAS u32x4*)(dst + 512 + F.lane * 8) = p1; }
        __syncthreads();
    }
}
__device__ __forceinline__ void combine_ln3(const Args& a, Frame& F) {
    const float* H = (const float*)(F.ws + WS_HA); const f16* Y = (const f16*)(F.ws + WS_Y); const int* SLOT = (const int*)(F.ws + WS_SLOT);
    const int gw = F.vcu * NWAVES + F.wave, NGW = F.G * NWAVES, lane = F.lane;
    f32x4 gv[4], bv[4];
#pragma unroll
    for (int j = 0; j < 4; ++j) { gv[j] = *(const GAS f32x4*)(a.ln3_g + 4 * lane + 256 * j); bv[j] = *(const GAS f32x4*)(a.ln3_b + 4 * lane + 256 * j); }
    for (int row = gw; row < T; row += NGW) { const int b = row / SEQ; f32x4 v[4];
#pragma unroll
        for (int j = 0; j < 4; ++j) v[j] = *(const GAS f32x4*)(H + (size_t)row * D + 4 * lane + 256 * j) * ALPHA;
        const int sl = (lane < NE) ? SLOT[(size_t)row * NE + lane] : -1;
        for (int e = 0; e < NE; ++e) { const int s = __builtin_amdgcn_readlane(sl, e); if (s < 0) continue;
            const f16* yp = Y + ((size_t)e * 2048 + b * CAP + s) * D + 4 * lane;
#pragma unroll
            for (int j = 0; j < 4; ++j) { const f16x4 yv = *(const GAS f16x4*)(yp + 256 * j); v[j] += (f32x4){(float)yv[0], (float)yv[1], (float)yv[2], (float)yv[3]}; } }
        float s = 0.f;
#pragma unroll
        for (int j = 0; j < 4; ++j) s += (v[j][0] + v[j][1]) + (v[j][2] + v[j][3]);
        const float mean = wave_sum(s) * (1.0f / D); float s2 = 0.f;
#pragma unroll
        for (int j = 0; j < 4; ++j) { v[j] = v[j] - mean; s2 += (v[j][0] * v[j][0] + v[j][1] * v[j][1]) + (v[j][2] * v[j][2] + v[j][3] * v[j][3]); }
        const float rstd = __builtin_amdgcn_rsqf(wave_sum(s2) * (1.0f / D) + EPS);
#pragma unroll
        for (int j = 0; j < 4; ++j) *(GAS f32x4*)(a.out + (size_t)row * D + 4 * lane + 256 * j) = v[j] * rstd * gv[j] + bv[j];
    }
}

constexpr int NPHASE = 14;
__global__ void __launch_bounds__(NTHR, 2) fwd(Args args) {
    extern __shared__ __attribute__((aligned(16))) unsigned char lds_raw[];
    Frame F; F.lds = (LAS unsigned char*)lds_raw; F.tid = threadIdx.x; F.lane = F.tid & 63; F.wave = __builtin_amdgcn_readfirstlane(F.tid >> 6);
    F.G = gridDim.x; { const int bx = blockIdx.x; F.vcu = (F.G % 8 == 0) ? (bx % 8) * (F.G / 8) + bx / 8 : bx; }
    F.ws = args.ws;
    unsigned char* ws = args.ws;
    volatile LAS unsigned* MISC = (volatile LAS unsigned*)(F.lds + MISC_OFF);
    for (int u = F.tid; u < (LDS_BYTES - RING_BYTES) / 4; u += NTHR) ((LAS unsigned*)(F.lds + RING_BYTES))[u] = 0u;
    __syncthreads();
    const int lo = args.ph_lo, hi = args.ph_hi;
    XcdBarrier bar; bar.bar = (unsigned*)(ws + WS_CTL) + CW_BAR; bar.x = 0; bar.st = nullptr;
    if (hi - lo > 1) bar = xcd_barrier_post((unsigned*)(ws + WS_CTL) + CW_BAR, MISC + 8);
#ifdef ONLY_PH
#define IN(k) ((k) == ONLY_PH && lo <= (k) && (k) < hi)
#else
#define IN(k) (lo <= (k) && (k) < hi)
#endif
#define SEAM(k) do { if (IN(k) && IN((k) + 1)) xcd_barrier(bar); } while (0)
    const char* wsc = (const char*)ws;
    float* RS = (float*)(ws + WS_CTL) + CW_RS;

    if (IN(0)) { frame_ids(F); p0_prologue(args, F); } SEAM(0);

    if (IN(1)) { frame_ids(F);
        SchedG1 S{F.vcu, F.G, wsc + WS_XH, wsc + WS_WIN, wsc + WS_MEMH, wsc + WS_XWK, wsc + WS_XWV};
        EpiG1 E{(f16*)(ws + WS_HCAT), (f16*)(ws + WS_MK), (f16*)(ws + WS_MVT), RS};
        pg8::gemm_phase<EpiG1, SchedG1, true>(F.lds, pg8::Gemm{1024, 1024, 1024}, S, E);
    } SEAM(1);

    if (IN(2)) { frame_ids(F);
        SchedGrid S{F.vcu, F.G, 7, 448, wsc + WS_HCAT, wsc + WS_WUP, (size_t)256 * LDH * 2, (size_t)256 * 384 * 2};
        EpiUP E{(f16*)(ws + WS_Q), (f16*)(ws + WS_K), (f16*)(ws + WS_V), RS, (const float*)(ws + WS_CS)};
        pg8::gemm_phase<EpiUP, SchedGrid, true>(F.lds, pg8::Gemm{LDH, 384, 384}, S, E);
        krope_pass(F);
        conv_phase(args, F);
    } SEAM(2);

    if (IN(3)) { frame_ids(F); attn_phase(F); } SEAM(3);

    if (IN(4)) { frame_ids(F);
        SchedGrid S{F.vcu, F.G, 4, 256, wsc + WS_AO, wsc + WS_WO, (size_t)256 * 1024 * 2, (size_t)256 * 1024 * 2};
        EpiPre E{args.x, (float*)(ws + WS_PRE)};
        pg8::gemm_phase<EpiPre, SchedGrid, true>(F.lds, pg8::Gemm{1024, 1024, 1024}, S, E);
    } SEAM(4);

    if (IN(5)) { frame_ids(F); ln_rows(F, (const float*)(ws + WS_PRE), args.ln1_g, args.ln1_b, (float*)(ws + WS_HA), (f16*)(ws + WS_HH)); } SEAM(5);

    if (IN(6)) { frame_ids(F);
        SchedGrid S{F.vcu, F.G, 4, 256, wsc + WS_HH, wsc + WS_XWQ, (size_t)256 * 1024 * 2, (size_t)256 * 1024 * 2};
        EpiH16 E{(f16*)(ws + WS_XQ), 1024, XSCALE};
        pg8::gemm_phase<EpiH16, SchedGrid, true>(F.lds, pg8::Gemm{1024, 1024, 1024}, S, E);
    } SEAM(6);

    if (IN(7)) { frame_ids(F);
        { SchedXS S{F.vcu, F.G, wsc + WS_XQ, wsc + WS_MK, 0}; EpiSoftmax E{(f16*)(ws + WS_P)};
          pg8::gemm_phase<EpiSoftmax, SchedXS, false>(F.lds, pg8::Gemm{1024, 1024, 256}, S, E); }
        VM_WAIT(); __syncthreads();
        { SchedXS S{F.vcu, F.G, wsc + WS_P, wsc + WS_MVT, 1}; EpiH16 E{(f16*)(ws + WS_XO), 1024, 1.0f};
          pg8::gemm_phase<EpiH16, SchedXS, true>(F.lds, pg8::Gemm{1024, MT, 256}, S, E); }
    } SEAM(7);

    if (IN(8)) { frame_ids(F);
        SchedGrid S{F.vcu, F.G, 4, 256, wsc + WS_XO, wsc + WS_XWO, (size_t)256 * 1024 * 2, (size_t)256 * 1024 * 2};
        EpiPre E{(const float*)(ws + WS_HA), (float*)(ws + WS_PRE)};
        pg8::gemm_phase<EpiPre, SchedGrid, true>(F.lds, pg8::Gemm{1024, 1024, 1024}, S, E);
    } SEAM(8);

    if (IN(9)) { frame_ids(F); ln2_router(args, F); } SEAM(9);

    if (IN(10)) { frame_ids(F); topk_phase(F); } SEAM(10);

    if (IN(11)) { frame_ids(F);
        SchedMoE S{F.vcu, F.G, 16, 2048, wsc + WS_XS, wsc + WS_WGU, (size_t)2048 * 1024 * 2, (size_t)4096 * 1024 * 2, (size_t)256 * 1024 * 2, (size_t)256 * 1024 * 2};
        EpiHid E{(f16*)(ws + WS_HID)};
        pg8::gemm_phase<EpiHid, SchedMoE, true>(F.lds, pg8::Gemm{1024, 1024, 1024}, S, E);
    } SEAM(11);

    if (IN(12)) { frame_ids(F);
        SchedMoE S{F.vcu, F.G, 4, 512, wsc + WS_HID, wsc + WS_WD, (size_t)2048 * 2048 * 2, (size_t)1024 * 2048 * 2, (size_t)256 * 2048 * 2, (size_t)256 * 2048 * 2};
        EpiY E{(f16*)(ws + WS_Y), (const float*)(ws + WS_GATE)};
        pg8::gemm_phase<EpiY, SchedMoE, true>(F.lds, pg8::Gemm{2048, 2048, 2048}, S, E);
    } SEAM(12);

    if (IN(13)) { frame_ids(F); combine_ln3(args, F); }
#undef IN
#undef SEAM
}

extern "C" void kernel_launch(void* const* d_in, const int* in_sizes, int n_in, void* d_out, int out_size, void* d_ws, size_t ws_size, hipStream_t stream) {
    static int ok = 0;
    if (ok == 0) {
        if (n_in != 28 || in_sizes[0] != T * D || out_size != T * D || ws_size < WS_END) {
            fprintf(stderr, "kernel_launch: shape mismatch: n_in %d in0 %d out %d ws %zu (need %zu)\n", n_in, n_in > 0 ? in_sizes[0] : -1, out_size, ws_size, (size_t)WS_END); ok = -1; return; }
        if (hipFuncSetAttribute((const void*)fwd, hipFuncAttributeMaxDynamicSharedMemorySize, LDS_BYTES) != hipSuccess) { fprintf(stderr, "kernel_launch: hipFuncSetAttribute failed\n"); ok = -1; return; }
        int per_cu = 0;
        if (hipOccupancyMaxActiveBlocksPerMultiprocessor(&per_cu, (const void*)fwd, NTHR, LDS_BYTES) != hipSuccess || per_cu < 1) fprintf(stderr, "kernel_launch: occupancy query reports %d blocks per CU\n", per_cu);
        (void)hipGetLastError();
        ok = 1;
    }
    if (ok < 0) return;
    (void)hipMemsetAsync((char*)d_ws + WS_CTL, 0, CTL_BYTES, stream);
    Args a{};
    a.x = (const float*)d_in[0]; a.mem = (const float*)d_in[1]; a.pos = (const int*)d_in[2]; a.w_in = (const float*)d_in[3]; a.q_norm_g = (const float*)d_in[4]; a.w_uq = (const float*)d_in[5];
    a.kv_norm_g = (const float*)d_in[6]; a.w_uk = (const float*)d_in[7]; a.w_uv = (const float*)d_in[8]; a.conv_w = (const float*)d_in[9]; a.conv_b = (const float*)d_in[10];
    a.conv_ln_g = (const float*)d_in[11]; a.conv_ln_b = (const float*)d_in[12]; a.w_o = (const float*)d_in[13]; a.ln1_g = (const float*)d_in[14]; a.ln1_b = (const float*)d_in[15];
    a.xa_w_q = (const float*)d_in[16]; a.xa_w_k = (const float*)d_in[17]; a.xa_w_v = (const float*)d_in[18]; a.xa_w_o = (const float*)d_in[19]; a.ln2_g = (const float*)d_in[20]; a.ln2_b = (const float*)d_in[21];
    a.w_router = (const float*)d_in[22]; a.w_gate = (const float*)d_in[23]; a.w_up = (const float*)d_in[24]; a.w_down = (const float*)d_in[25]; a.ln3_g = (const float*)d_in[26]; a.ln3_b = (const float*)d_in[27];
    a.out = (float*)d_out; a.ws = (unsigned char*)d_ws;
    for (int i = 0; i < 16; ++i) a.invf[i] = powf(10000.0f, -(float)(2 * i) / 32.0f);
#if MK_N_LAUNCHES == 1
    a.ph_lo = 0; a.ph_hi = NPHASE;
    hipLaunchKernelGGL(fwd, dim3(GRID), dim3(NTHR), LDS_BYTES, stream, a);
#else
    for (int p = 0; p < NPHASE; ++p) { a.ph_lo = p; a.ph_hi = p + 1; hipLaunchKernelGGL(fwd, dim3(GRID), dim3(NTHR), LDS_BYTES, stream, a); }
#endif
    const hipError_t le = hipPeekAtLastError();
    if (le != hipSuccess) fprintf(stderr, "kernel_launch: launch failed: %s\n", hipGetErrorName(le));
}
```

```cpp
#include <hip/hip_runtime.h>
#include <cstdio>
#include <cstdint>
#include <cmath>

#define LAS __attribute__((address_space(3)))
#define GAS __attribute__((address_space(1)))
typedef _Float16 f16;
typedef _Float16 f16x2 __attribute__((ext_vector_type(2)));
typedef _Float16 f16x4 __attribute__((ext_vector_type(4)));
typedef _Float16 f16x8 __attribute__((ext_vector_type(8)));
typedef float f32x2 __attribute__((ext_vector_type(2)));
typedef float f32x4 __attribute__((ext_vector_type(4)));
typedef float f32x16 __attribute__((ext_vector_type(16)));
typedef unsigned u32x2 __attribute__((ext_vector_type(2)));
typedef unsigned u32x4 __attribute__((ext_vector_type(4)));
typedef short s16x4 __attribute__((ext_vector_type(4)));
typedef GAS unsigned gu32;

#ifndef MK_N_LAUNCHES
#define MK_N_LAUNCHES 1
#endif
#ifndef DUP_MASK
#define DUP_MASK 0
#endif
#ifndef NAIVE_ATTN
#define NAIVE_ATTN 0
#endif

constexpr int NB = 8, SEQ = 2048, T = NB * SEQ, D = 1024;
constexpr int LDH = 1536;
constexpr int MEML = 256, MT = NB * MEML;
constexpr int NE = 16, FF = 2048, CAP = 256;
constexpr int CCH = 512, CW = 31, CPAD = 15;
constexpr float EPS = 1e-5f;
constexpr float ALPHA = 1.189207115002721f;
constexpr float LOG2E = 1.4426950408889634f;
constexpr float QSCALE = LOG2E * 0.10206207261596577f;
constexpr float XSCALE = LOG2E / 16.0f;
constexpr int NWAVES = 8, NTHR = 512, GRID = 256;

constexpr size_t MiB = 1ull << 20;
constexpr size_t WS_CTL = 0, CTL_BYTES = MiB;
constexpr size_t WS_WIN = 1 * MiB, WS_WUP = 4 * MiB, WS_WO = 6 * MiB, WS_XWQ = 8 * MiB, WS_XWK = 10 * MiB, WS_XWV = 12 * MiB, WS_XWO = 14 * MiB;
constexpr size_t WS_CS = 16 * MiB, WS_AFF = 19 * MiB, WS_SLOT = 20 * MiB, WS_TOK = 21 * MiB, WS_GATE = 21 * MiB + 512 * 1024, WS_MK = 22 * MiB, WS_MVT = 26 * MiB;
constexpr size_t WS_WGU = 32 * MiB, WS_WD = 160 * MiB, WS_HA = 224 * MiB;
constexpr size_t WS_XH = 288 * MiB, WS_MEMH = 320 * MiB, WS_HCAT = 324 * MiB, WS_Q = 372 * MiB, WS_K = 396 * MiB, WS_V = 420 * MiB, WS_AO = 436 * MiB;
constexpr size_t WS_PRE = 288 * MiB, WS_HH = 352 * MiB, WS_XQ = 384 * MiB, WS_P = 416 * MiB, WS_XO = 448 * MiB;
constexpr size_t WS_XS = 288 * MiB, WS_HID = 384 * MiB, WS_Y = 32 * MiB;
constexpr size_t WS_END = 512 * MiB;
constexpr int CW_TMO = 0, CW_BAR = 4096, CW_RS = 131072;

constexpr int RING_BYTES = 131072, MISC_OFF = RING_BYTES + 320, LDS_BYTES = 147456;

#define LDS_WAIT() asm volatile("s_waitcnt lgkmcnt(0)" ::: "memory")
#define VM_WAIT() asm volatile("s_waitcnt vmcnt(0)" ::: "memory")
#define RLX_AGENT __ATOMIC_RELAXED, __HIP_MEMORY_SCOPE_AGENT

__device__ __forceinline__ int opaque_tid() { int t; asm volatile("v_mov_b32_e32 %0, %1" : "=v"(t) : "v"(threadIdx.x)); return t; }
__device__ __forceinline__ unsigned pk_h2(float lo, float hi) { f32x2 v = {lo, hi}; f16x2 h = __builtin_convertvector(v, f16x2); return __builtin_bit_cast(unsigned, h); }
__device__ __forceinline__ float wave_sum(float v) {
#pragma unroll
    for (int o = 1; o < 64; o <<= 1) v += __shfl_xor(v, o);
    return v;
}

#define XB_TMO      128
#define XB_XCNT(j)  (256  + 64 * (j))
#define XB_XSUB(j)  (1280 + 64 * (j))
#define XB_XGEN(j)  (2304 + 64 * (j))
#define XB_TOP      3328
#define XB_TOPGEN   3392
#define XCD_BAR_WORDS 3456
#define XB_SPIN_CAP (1u << 18)
__device__ __forceinline__ unsigned xb_ld(unsigned* p)              { return __hip_atomic_load(p, __ATOMIC_RELAXED, __HIP_MEMORY_SCOPE_AGENT); }
__device__ __forceinline__ unsigned xb_add(unsigned* p, unsigned v) { return __hip_atomic_fetch_add(p, v, __ATOMIC_RELAXED, __HIP_MEMORY_SCOPE_AGENT); }
__device__ __forceinline__ unsigned xb_xcc_id() { return (unsigned)__builtin_amdgcn_s_getreg((3 << 11) | 20) & 0xFu; }
#define XB_SPIN(cond, bar) do { unsigned _sp = 0; while (cond) { __builtin_amdgcn_s_sleep(1); \
    if ((++_sp & 255u) == 0u) { if (xb_ld(&(bar)[XB_TMO])) break; if (_sp > XB_SPIN_CAP) { atomicAdd(&(bar)[XB_TMO], 1u); break; } } } } while (0)
struct XcdBarrier { unsigned* bar; unsigned x; volatile LAS unsigned* st; };
__device__ __forceinline__ XcdBarrier xcd_barrier_post(unsigned* bar, volatile LAS unsigned* st) {
    XcdBarrier b; b.bar = bar; b.x = xb_xcc_id(); b.st = st;
    if (threadIdx.x == 0) (void)xb_add(&bar[XB_XCNT(b.x)], 1u);
    return b;
}
__device__ __forceinline__ void xcd_barrier_complete(unsigned* bar, unsigned x, unsigned& nloc, unsigned& nx) {
    const unsigned G = gridDim.x * gridDim.y * gridDim.z;
    unsigned sum, cnt, mine, sp = 0u;
    for (;;) {
        sum = 0u; cnt = 0u; mine = 0u;
#pragma unroll
        for (unsigned j = 0; j < 16; ++j) { const unsigned c = xb_ld(&bar[XB_XCNT(j)]); sum += c; cnt += (c > 0u) ? 1u : 0u; mine = (j == x) ? c : mine; }
        if (sum == G) break;
        __builtin_amdgcn_s_sleep(1);
        if ((++sp & 255u) == 0u) { if (xb_ld(&bar[XB_TMO])) break; if (sp > XB_SPIN_CAP) { atomicAdd(&bar[XB_TMO], 1u); break; } }
    }
    nloc = mine > 0u ? mine : 1u; nx = cnt > 0u ? cnt : 1u;
}
__device__ __forceinline__ void xcd_barrier(const XcdBarrier& b) {
    asm volatile("s_waitcnt vmcnt(0)" ::: "memory");
    __syncthreads();
    if (threadIdx.x == 0) {
        unsigned* bar = b.bar;
        __builtin_amdgcn_s_waitcnt(0);
        unsigned nloc = b.st[0], nx = b.st[1];
        if (nloc == 0u) { xcd_barrier_complete(bar, b.x, nloc, nx); b.st[0] = nloc; b.st[1] = nx; }
        const unsigned old = xb_add(&bar[XB_XSUB(b.x)], 1u);
        const unsigned gen = old / nloc;
        if (old + 1u == (gen + 1u) * nloc) {
            __builtin_amdgcn_fence(__ATOMIC_RELEASE, "agent");
            asm volatile("s_waitcnt vmcnt(0)" ::: "memory");
            const unsigned og = xb_add(&bar[XB_TOP], 1u);
            const unsigned tg = og / nx;
            if (og + 1u == (tg + 1u) * nx) xb_add(&bar[XB_TOPGEN], 1u);
            else XB_SPIN(xb_ld(&bar[XB_TOPGEN]) == tg, bar);
            __builtin_amdgcn_fence(__ATOMIC_ACQUIRE, "agent");
            xb_add(&bar[XB_XGEN(b.x)], 1u);
            asm volatile("s_waitcnt vmcnt(0)" ::: "memory");
        } else {
            XB_SPIN(xb_ld(&bar[XB_XGEN(b.x)]) == gen, bar);
            __builtin_amdgcn_fence(__ATOMIC_ACQUIRE, "agent");
            asm volatile("s_waitcnt vmcnt(0)" ::: "memory");
        }
    }
    __syncthreads();
}

namespace pg8 {
constexpr int BM = 256, BK = 64, HALF = 128, HTB = HALF * BK * 2;
__host__ __device__ __forceinline__ int lds_byte(int r, int c) { const int st = (r >> 4) * 2 + (c >> 5), rr = r & 15, cc = c & 31, ob = rr * 64 + cc * 2; return st * 1024 + (ob ^ (((ob >> 9) & 1) << 5)); }
__host__ __device__ __forceinline__ void stage_rc(int b, int& R, int& C) { const int st = b / 1024, sb = b % 1024, swz = sb ^ (((sb >> 9) & 1) << 5); R = (st >> 1) * 16 + swz / 64; C = (st & 1) * 32 + (swz % 64) / 2; }
__host__ __device__ __forceinline__ int perm32(int rho) { const int n = rho >> 4, i = rho & 15; return 8 * (i >> 2) + 4 * n + (i & 3); }

struct Unit { int pm, pn, z; const char* A; const char* B; };
struct Gemm { int lda, ldb, K; };

template <class Epi, class Sched, bool ALIGN_EPI>
__device__ __forceinline__ void gemm_phase(LAS unsigned char* lds, const Gemm g, const Sched& S, const Epi& E) {
    const int tid = opaque_tid(), wid = __builtin_amdgcn_readfirstlane(tid >> 6), lane = tid & 63, wr = wid >> 2, wc = wid & 3, fr = lane & 15, fq = lane >> 4;
    const int K = g.K, nt = K / BK;
    unsigned voffA[2], voffB[2];
#pragma unroll
    for (int i = 0; i < 2; ++i) { int R, C; stage_rc(tid * 16 + i * 8192, R, C); const int Rb = Epi::PERM ? ((R & ~31) + perm32(R & 31)) : R;
        voffA[i] = (unsigned)(R * g.lda + C) * 2u; voffB[i] = (unsigned)(Rb * g.ldb + C) * 2u; }
    const size_t kstep = (size_t)(BK * 2);
    const size_t hstepA = (size_t)HALF * g.lda * 2, hstepB = (size_t)HALF * g.ldb * 2;
    const unsigned ldsw = (unsigned)wid * 1024u;
    const int aoff = lds_byte(wr * 64 + fr, fq * 8), boff = lds_byte(wc * 32 + fr, fq * 8);
#define PG8_SA(b, h) (((b) * 2 + (h)) * HTB)
#define PG8_SB(b, h) ((4 + (b) * 2 + (h)) * HTB)
#define PG8_STAGE(bufoff, gbase, voff) do { _Pragma("unroll") for (int _i = 0; _i < 2; ++_i) \
        __builtin_amdgcn_global_load_lds((const unsigned*)((const char*)(gbase) + (voff)[_i]), (LAS unsigned*)(lds + (bufoff) + ldsw + _i * 8192), 16, 0, 0); } while (0)
#define PG8_LDA(dst, b, h) do { _Pragma("unroll") for (int m = 0; m < 4; ++m) _Pragma("unroll") for (int k = 0; k < 2; ++k) dst[m][k] = *(const LAS f16x8*)(lds + PG8_SA(b, h) + aoff + m * 2048 + k * 1024); } while (0)
#define PG8_LDB(dst, b, h) do { _Pragma("unroll") for (int n = 0; n < 2; ++n) _Pragma("unroll") for (int k = 0; k < 2; ++k) dst[n][k] = *(const LAS f16x8*)(lds + PG8_SB(b, h) + boff + n * 2048 + k * 1024); } while (0)
#define PG8_MMA(ai, bj, At, Bt) do { __builtin_amdgcn_s_setprio(1); _Pragma("unroll") for (int m = 0; m < 4; ++m) _Pragma("unroll") for (int n = 0; n < 2; ++n) _Pragma("unroll") for (int k = 0; k < 2; ++k) \
        acc[ai][bj][m][n] = __builtin_amdgcn_mfma_f32_16x16x32_f16(Bt[n][k], At[m][k], acc[ai][bj][m][n], 0, 0, 0); __builtin_amdgcn_s_setprio(0); } while (0)
#define PG8_WAIT_V(n) asm volatile("s_waitcnt vmcnt(" #n ")" ::: "memory")
#define PG8_WAIT_L(n) asm volatile("s_waitcnt lgkmcnt(" #n ")" ::: "memory")
#define PG8_BAR __builtin_amdgcn_s_barrier()
#define PG8_SCHED __builtin_amdgcn_sched_barrier(0)
    Unit cur, nxt; int ui = 0;
    if (!S.next(0, cur)) return;
    f32x4 acc[2][2][4][2];
#pragma unroll
    for (int a = 0; a < 2; ++a)
#pragma unroll
        for (int b = 0; b < 2; ++b)
#pragma unroll
            for (int m = 0; m < 4; ++m)
#pragma unroll
                for (int n = 0; n < 2; ++n) acc[a][b][m][n] = (f32x4){0.f, 0.f, 0.f, 0.f};
    f16x8 At[4][2], B0[2][2], B1[2][2];
    const char* cA = cur.A; const char* cB = cur.B;
    PG8_STAGE(PG8_SB(0, 0), cB, voffB); PG8_STAGE(PG8_SB(0, 1), cB + hstepB, voffB); PG8_STAGE(PG8_SA(0, 0), cA, voffA); PG8_STAGE(PG8_SA(0, 1), cA + hstepA, voffA);
    if (wr == 1) PG8_BAR;
    PG8_WAIT_V(2); PG8_BAR;
    PG8_STAGE(PG8_SB(1, 0), cB + kstep, voffB); PG8_STAGE(PG8_SA(1, 0), cA + kstep, voffA); PG8_STAGE(PG8_SB(1, 1), cB + hstepB + kstep, voffB);
    PG8_WAIT_V(6); PG8_BAR;
    for (;;) {
        const bool has_next = S.next(ui + 1, nxt);
        const char* nA = has_next ? nxt.A : cA; const char* nB = has_next ? nxt.B : cB;
#pragma clang loop unroll(disable)
        for (int t = 0; t < nt; t += 2) {
            const bool last = (t == nt - 2);
            const char* a1 = cA + (size_t)(t + 1) * kstep;
            const char* a2 = last ? nA : cA + (size_t)(t + 2) * kstep; const char* b2 = last ? nB : cB + (size_t)(t + 2) * kstep;
            const char* a3 = a2 + kstep; const char* b3 = b2 + kstep;
            PG8_LDB(B0, 0, 0); PG8_LDB(B1, 0, 1); PG8_SCHED; PG8_LDA(At, 0, 0); PG8_STAGE(PG8_SA(1, 1), a1 + hstepA, voffA);
            PG8_WAIT_V(8); PG8_WAIT_L(0); PG8_BAR; PG8_MMA(0, 0, At, B0); PG8_MMA(0, 1, At, B1); PG8_BAR; PG8_SCHED;
            PG8_LDA(At, 0, 1); PG8_STAGE(PG8_SB(0, 0), b2, voffB); PG8_STAGE(PG8_SB(0, 1), b2 + hstepB, voffB); PG8_STAGE(PG8_SA(0, 0), a2, voffA);
            PG8_WAIT_V(8); PG8_WAIT_L(0); PG8_BAR; PG8_MMA(1, 0, At, B0); PG8_MMA(1, 1, At, B1); PG8_BAR; PG8_SCHED;
            PG8_LDB(B0, 1, 0); PG8_LDB(B1, 1, 1); PG8_SCHED; PG8_LDA(At, 1, 0); PG8_STAGE(PG8_SA(0, 1), a2 + hstepA, voffA);
            PG8_WAIT_V(8); PG8_WAIT_L(0); PG8_BAR; PG8_MMA(0, 0, At, B0); PG8_MMA(0, 1, At, B1); PG8_BAR; PG8_SCHED;
            PG8_LDA(At, 1, 1); PG8_STAGE(PG8_SB(1, 0), b3, voffB); PG8_STAGE(PG8_SB(1, 1), b3 + hstepB, voffB); PG8_STAGE(PG8_SA(1, 0), a3, voffA);
            PG8_WAIT_V(8); PG8_WAIT_L(0); PG8_BAR; PG8_MMA(1, 0, At, B0); PG8_MMA(1, 1, At, B1); PG8_BAR; PG8_SCHED;
        }
        if constexpr (ALIGN_EPI) { if (wr == 0) PG8_BAR; }
        if constexpr (!Epi::AFTER_DRAIN) { E(acc, cur, wr, wc, fr, fq); }
        if (!has_next) break;
#pragma unroll
        for (int a = 0; a < 2; ++a)
#pragma unroll
            for (int b = 0; b < 2; ++b)
#pragma unroll
                for (int m = 0; m < 4; ++m)
#pragma unroll
                    for (int n = 0; n < 2; ++n) acc[a][b][m][n] = (f32x4){0.f, 0.f, 0.f, 0.f};
        cur = nxt; cA = nA; cB = nB; ++ui;
        if constexpr (ALIGN_EPI) { if (wr == 1) PG8_BAR; }
    }
    PG8_WAIT_V(0);
    if constexpr (!ALIGN_EPI) { if (wr == 0) PG8_BAR; }
    PG8_BAR;
    if constexpr (Epi::AFTER_DRAIN) { E.fused(acc, cur, wr, wc, fr, fq, lds, wid, lane); }
#undef PG8_SA
#undef PG8_SB
#undef PG8_STAGE
#undef PG8_LDA
#undef PG8_LDB
#undef PG8_MMA
#undef PG8_WAIT_V
#undef PG8_WAIT_L
#undef PG8_BAR
#undef PG8_SCHED
}
}
using pg8::Unit;

struct Args {
    const float* x; const float* mem; const int* pos; const float* w_in; const float* q_norm_g; const float* w_uq; const float* kv_norm_g; const float* w_uk; const float* w_uv;
    const float* conv_w; const float* conv_b; const float* conv_ln_g; const float* conv_ln_b; const float* w_o; const float* ln1_g; const float* ln1_b;
    const float* xa_w_q; const float* xa_w_k; const float* xa_w_v; const float* xa_w_o; const float* ln2_g; const float* ln2_b;
    const float* w_router; const float* w_gate; const float* w_up; const float* w_down; const float* ln3_g; const float* ln3_b;
    float* out; unsigned char* ws;
    float invf[16];
    int ph_lo, ph_hi;
};

struct Frame { LAS unsigned char* lds; int tid, lane, wave, vcu, G; unsigned char* ws; };
__device__ __forceinline__ void frame_ids(Frame& F) { const int t = opaque_tid(); F.tid = t; F.lane = t & 63; F.wave = __builtin_amdgcn_readfirstlane(t >> 6); }

template <int MODE>
__device__ __forceinline__ void tr_item(const float* W, int K, int N, f16* WT, int ldt, int row_off, int col_off, const float* kscale, LAS float* scr, int item, int lane) {
    const int nblk = N / 32, kb = item / nblk, nb = item % nblk, k0 = 64 * kb, n0 = 32 * nb;
    const float* wp = W + (size_t)(k0 + (lane >> 5)) * N + n0 + (lane & 31);
    float v[32];
#pragma unroll
    for (int i = 0; i < 32; ++i) v[i] = wp[(size_t)(2 * i) * N];
    if (kscale) {
#pragma unroll
        for (int i = 0; i < 32; ++i) v[i] *= kscale[k0 + 2 * i + (lane >> 5)]; }
#pragma unroll
    for (int i = 0; i < 32; ++i) scr[(2 * i + (lane >> 5)) * 33 + (lane & 31)] = v[i];
    LDS_WAIT(); asm volatile("" ::: "memory");
    const int c = lane & 7;
#pragma unroll
    for (int j = 0; j < 4; ++j) { const int n = (lane >> 3) + 8 * j; const LAS float* s = scr + (8 * c) * 33 + n;
        u32x4 o; o.x = pk_h2(s[0 * 33], s[1 * 33]); o.y = pk_h2(s[2 * 33], s[3 * 33]); o.z = pk_h2(s[4 * 33], s[5 * 33]); o.w = pk_h2(s[6 * 33], s[7 * 33]);
        const int nn = n0 + n; const int drow = (MODE == 0) ? (row_off + nn) : (row_off + 256 * (nn >> 7) + (nn & 127));
        *(GAS u32x4*)(WT + (size_t)drow * ldt + col_off + k0 + 8 * c) = o; }
    LDS_WAIT(); asm volatile("" ::: "memory");
}
__device__ __forceinline__ void cvt_rows(const float* src, f16* dst, size_t n8, int gw, int NGW, int lane) {
    for (size_t i0 = (size_t)gw * 256 + lane; i0 < n8; i0 += (size_t)NGW * 256) {
        f32x4 a[4], b[4];
#pragma unroll
        for (int q = 0; q < 4; ++q) { a[q] = *(const GAS f32x4*)(src + (i0 + 64 * q) * 8); b[q] = *(const GAS f32x4*)(src + (i0 + 64 * q) * 8 + 4); }
#pragma unroll
        for (int q = 0; q < 4; ++q) { u32x4 o; o.x = pk_h2(a[q].x, a[q].y); o.y = pk_h2(a[q].z, a[q].w); o.z = pk_h2(b[q].x, b[q].y); o.w = pk_h2(b[q].z, b[q].w);
            *(GAS u32x4*)(dst + (i0 + 64 * q) * 8) = o; } }
}
__device__ __forceinline__ void zero_block(f16* base, int ld, int nrows, int ncols8, int gw, int NGW, int lane) {
    const u32x4 z = {0u, 0u, 0u, 0u};
    for (size_t i = (size_t)gw * 64 + lane; i < (size_t)nrows * ncols8; i += (size_t)NGW * 64) { const size_t r = i / ncols8, c = i % ncols8; *(GAS u32x4*)(base + r * ld + c * 8) = z; }
}
typedef const __attribute__((address_space(4))) Args* KArgs;
__device__ __forceinline__ void p0_prologue(KArgs ap, Frame& F) { const auto& a = *ap;
    LAS float* scr = (LAS float*)(F.lds + F.wave * 16384);
    const int gw = F.vcu * NWAVES + F.wave, NGW = F.G * NWAVES, lane = F.lane;
    unsigned char* ws = F.ws;
    f16* WIN = (f16*)(ws + WS_WIN); f16* WUP = (f16*)(ws + WS_WUP); f16* WGU = (f16*)(ws + WS_WGU); f16* WD = (f16*)(ws + WS_WD);
    constexpr int I_IN = 16 * 45, I_UQ = 4 * 24, I_UK = 2 * 16, I_SQ = 16 * 32, I_G = 16 * 64, I_DN = 32 * 32;
    constexpr int NSMALL = I_IN + I_UQ + 2 * I_UK + 5 * I_SQ;
    constexpr int NITEMS = NSMALL + NE * (2 * I_G + I_DN);
    for (int it = gw; it < NITEMS; it += NGW) {
        int r = it;
        if (r < I_IN) { tr_item<0>(a.w_in, 1024, 1440, WIN, 1024, 0, 0, nullptr, scr, r, lane); continue; } r -= I_IN;
        if (r < I_UQ) { tr_item<0>(a.w_uq, 256, 768, WUP, 384, 0, 0, a.q_norm_g, scr, r, lane); continue; } r -= I_UQ;
        if (r < I_UK) { tr_item<0>(a.w_uk, 128, 512, WUP, 384, 768, 256, a.kv_norm_g, scr, r, lane); continue; } r -= I_UK;
        if (r < I_UK) { tr_item<0>(a.w_uv, 128, 512, WUP, 384, 1280, 256, a.kv_norm_g, scr, r, lane); continue; } r -= I_UK;
        if (r < I_SQ) { tr_item<0>(a.w_o, 1024, 1024, (f16*)(ws + WS_WO), 1024, 0, 0, nullptr, scr, r, lane); continue; } r -= I_SQ;
        if (r < I_SQ) { tr_item<0>(a.xa_w_q, 1024, 1024, (f16*)(ws + WS_XWQ), 1024, 0, 0, nullptr, scr, r, lane); continue; } r -= I_SQ;
        if (r < I_SQ) { tr_item<0>(a.xa_w_k, 1024, 1024, (f16*)(ws + WS_XWK), 1024, 0, 0, nullptr, scr, r, lane); continue; } r -= I_SQ;
        if (r < I_SQ) { tr_item<0>(a.xa_w_v, 1024, 1024, (f16*)(ws + WS_XWV), 1024, 0, 0, nullptr, scr, r, lane); continue; } r -= I_SQ;
        if (r < I_SQ) { tr_item<0>(a.xa_w_o, 1024, 1024, (f16*)(ws + WS_XWO), 1024, 0, 0, nullptr, scr, r, lane); continue; } r -= I_SQ;
        const int e = r / (2 * I_G + I_DN); r -= e * (2 * I_G + I_DN);
        if (r < I_G) { tr_item<1>(a.w_gate + (size_t)e * 1024 * 2048, 1024, 2048, WGU + (size_t)e * 4096 * 1024, 1024, 0, 0, nullptr, scr, r, lane); continue; } r -= I_G;
        if (r < I_G) { tr_item<1>(a.w_up + (size_t)e * 1024 * 2048, 1024, 2048, WGU + (size_t)e * 4096 * 1024, 1024, 128, 0, nullptr, scr, r, lane); continue; } r -= I_G;
        tr_item<0>(a.w_down + (size_t)e * 2048 * 1024, 2048, 1024, WD + (size_t)e * 1024 * 2048, 2048, 0, 0, nullptr, scr, r, lane);
    }
    zero_block(WIN + (size_t)1440 * 1024, 1024, 96, 128, gw, NGW, lane);
    zero_block(WUP + 256, 384, 768, 16, gw, NGW, lane);
    zero_block(WUP + (size_t)768 * 384, 384, 1024, 32, gw, NGW, lane);
    cvt_rows(a.x, (f16*)(ws + WS_XH), (size_t)T * D / 8, gw, NGW, lane);
    cvt_rows(a.mem, (f16*)(ws + WS_MEMH), (size_t)MT * D / 8, gw, NGW, lane);
    float* CS = (float*)(ws + WS_CS);
    for (int i = gw * 64 + lane; i < T * 16; i += NGW * 64) {
        const int t = i >> 4, k = i & 15; const float ang = (float)a.pos[t] * a.invf[k];
        const double rev = (double)ang * 0.15915494309189533577; const float fr = (float)(rev - floor(rev));
        *(GAS f32x2*)(CS + (size_t)i * 2) = (f32x2){__builtin_amdgcn_cosf(fr), __builtin_amdgcn_sinf(fr)}; }
}

struct SchedG1 { int vcu, G; const char* XH; const char* WIN; const char* MEMH; const char* XWK; const char* XWV;
    __device__ __forceinline__ bool next(int i, Unit& u) const { const int L = i * G + vcu; if (L >= 448) return false;
        if (L < 384) { u.z = 0; u.pm = L / 6; u.pn = L % 6; u.A = XH + (size_t)u.pm * 256 * 1024 * 2; u.B = WIN + (size_t)u.pn * 256 * 1024 * 2; }
        else { const int j = L - 384;
            if (j < 32) { u.z = 1; u.pm = j >> 2; u.pn = j & 3; u.A = MEMH + (size_t)u.pm * 256 * 1024 * 2; u.B = XWK + (size_t)u.pn * 256 * 1024 * 2; }
            else { const int q = j - 32; u.z = 2; u.pm = q >> 3; u.pn = q & 7; u.A = XWV + (size_t)u.pm * 256 * 1024 * 2; u.B = MEMH + (size_t)u.pn * 256 * 1024 * 2; } }
        return true; } };
struct SchedGrid { int vcu, G, nN, total; const char* A; const char* B; size_t astep, bstep;
    __device__ __forceinline__ bool next(int i, Unit& u) const { const int L = i * G + vcu; if (L >= total) return false;
        u.z = 0; u.pm = L / nN; u.pn = L % nN; u.A = A + (size_t)u.pm * astep; u.B = B + (size_t)u.pn * bstep; return true; } };
struct SchedXS { int vcu, G; const char* A; const char* B; int mode;
    __device__ __forceinline__ bool next(int i, Unit& u) const { const int L = i * G + vcu; if (L >= 256) return false;
        const int b = L >> 5, h = (L >> 3) & 3, qb = L & 7; u.z = b; u.pm = b * 8 + qb; u.pn = h;
        u.A = A + ((size_t)(b * SEQ + qb * 256) * 1024 + h * 256) * 2;
        u.B = (mode == 0) ? B + ((size_t)(b * MEML) * 1024 + h * 256) * 2 : B + ((size_t)(h * 256) * MT + b * MEML) * 2;
        return true; } };
struct SchedMoE { int vcu, G, npn, total; const char* A; const char* B; size_t a_e, b_e, astep, bstep;
    __device__ __forceinline__ bool next(int i, Unit& u) const { const int L = i * G + vcu; if (L >= total) return false;
        const int per = 8 * npn, e = L / per, r = L % per; u.z = e; u.pn = r >> 3; u.pm = r & 7;
        u.A = A + (size_t)e * a_e + (size_t)u.pm * astep; u.B = B + (size_t)e * b_e + (size_t)u.pn * bstep; return true; } };

struct EpiG1 {
    static constexpr bool PERM = true, AFTER_DRAIN = false;
    f16* HCAT; f16* MK; f16* MVT; float* RS;
    __device__ __forceinline__ void operator()(const f32x4 (&acc)[2][2][4][2], const Unit& u, int wr, int wc, int fr, int fq) const {
        f16* base; int ld;
        if (u.z == 0) { base = HCAT + (size_t)(u.pm * 256) * LDH + u.pn * 256; ld = LDH; }
        else if (u.z == 1) { base = MK + (size_t)(u.pm * 256) * 1024 + u.pn * 256; ld = 1024; }
        else { base = MVT + (size_t)(u.pm * 256) * MT + u.pn * 256; ld = MT; }
        const int row0 = wr * 64 + fr, col0 = wc * 32 + 8 * fq;
        const bool stat = (u.z == 0 && u.pn < 2);
#pragma unroll
        for (int ai = 0; ai < 2; ++ai)
#pragma unroll
            for (int m = 0; m < 4; ++m) { const int row = row0 + ai * 128 + m * 16; f16* rowp = base + (size_t)row * ld + col0; float ss[2];
#pragma unroll
                for (int bj = 0; bj < 2; ++bj) { const f32x4 v0 = acc[ai][bj][m][0], v1 = acc[ai][bj][m][1];
                    u32x4 w; w.x = pk_h2(v0[0], v0[1]); w.y = pk_h2(v0[2], v0[3]); w.z = pk_h2(v1[0], v1[1]); w.w = pk_h2(v1[2], v1[3]);
                    *(GAS u32x4*)(rowp + bj * 128) = w;
                    ss[bj] = (v0[0] * v0[0] + v0[1] * v0[1]) + (v0[2] * v0[2] + v0[3] * v0[3]) + (v1[0] * v1[0] + v1[1] * v1[1]) + (v1[2] * v1[2] + v1[3] * v1[3]); }
                if (stat) { float s = (u.pn == 0) ? ss[0] + ss[1] : ss[0]; s += __shfl_xor(s, 16); s += __shfl_xor(s, 32);
                    if (fq == 0) atomicAdd(RS + (size_t)(u.pm * 256 + row) * 2 + u.pn, s); } }
    }
};
struct EpiUP {
    static constexpr bool PERM = false, AFTER_DRAIN = false;
    f16* Q; f16* Kb; f16* V; const float* RS; const float* CS;
    __device__ __forceinline__ void operator()(const f32x4 (&acc)[2][2][4][2], const Unit& u, int wr, int wc, int fr, int fq) const {
        const int pn = u.pn, row0 = u.pm * 256 + wr * 64 + fr;
#pragma unroll
        for (int ai = 0; ai < 2; ++ai)
#pragma unroll
            for (int m = 0; m < 4; ++m) { const int row = row0 + ai * 128 + m * 16;
                const f32x2 rs = *(const GAS f32x2*)(RS + (size_t)row * 2);
                if (pn < 3) { const float sc = __builtin_amdgcn_rsqf(rs.x * (1.0f / 256.0f) + EPS) * QSCALE;
#pragma unroll
                    for (int bj = 0; bj < 2; ++bj) { const int g32 = 8 * pn + 4 * bj + wc; f32x4 x0 = acc[ai][bj][m][0] * sc, x1 = acc[ai][bj][m][1] * sc;
                        if (g32 % 3 == 2) { const f32x4 c01 = *(const GAS f32x4*)(CS + (size_t)row * 32 + fq * 8), c23 = *(const GAS f32x4*)(CS + (size_t)row * 32 + fq * 8 + 4);
                            const f32x4 cs = {c01[0], c01[2], c23[0], c23[2]}, sn = {c01[1], c01[3], c23[1], c23[3]};
                            const f32x4 o0 = x0 * cs - x1 * sn, o1 = x1 * cs + x0 * sn; x0 = o0; x1 = o1; }
                        f16* p = Q + (size_t)row * 768 + g32 * 32 + 4 * fq;
                        *(GAS u32x2*)p = (u32x2){pk_h2(x0[0], x0[1]), pk_h2(x0[2], x0[3])}; *(GAS u32x2*)(p + 16) = (u32x2){pk_h2(x1[0], x1[1]), pk_h2(x1[2], x1[3])}; }
                } else { const float sc = __builtin_amdgcn_rsqf(rs.y * (1.0f / 128.0f) + EPS);
#pragma unroll
                    for (int bj = 0; bj < 2; ++bj)
#pragma unroll
                        for (int n = 0; n < 2; ++n) { const f32x4 x = acc[ai][bj][m][n] * sc; const int c = 256 * ((pn - 3) & 1) + 128 * bj + 32 * wc + 16 * n + 4 * fq;
                            f16* p = (pn < 5) ? Kb + (size_t)row * 768 + (c >> 6) * 96 + (c & 63) : V + (size_t)row * 512 + c;
                            *(GAS u32x2*)p = (u32x2){pk_h2(x[0], x[1]), pk_h2(x[2], x[3])}; }
                }
                asm volatile("" ::: "memory"); }
    }
};
struct EpiPre {
    static constexpr bool PERM = false, AFTER_DRAIN = false;
    const float* R; float* PRE;
    __device__ __forceinline__ void operator()(const f32x4 (&acc)[2][2][4][2], const Unit& u, int wr, int wc, int fr, int fq) const {
        const int row0 = u.pm * 256 + wr * 64 + fr, col0 = u.pn * 256 + wc * 32 + 4 * fq;
#pragma unroll
        for (int ai = 0; ai < 2; ++ai)
#pragma unroll
            for (int m = 0; m < 4; ++m) { const size_t off = (size_t)(row0 + ai * 128 + m * 16) * D + col0;
#pragma unroll
                for (int bj = 0; bj < 2; ++bj)
#pragma unroll
                    for (int n = 0; n < 2; ++n) { const f32x4 r = *(const GAS f32x4*)(R + off + bj * 128 + n * 16); *(GAS f32x4*)(PRE + off + bj * 128 + n * 16) = acc[ai][bj][m][n] + r * ALPHA; } }
    }
};
struct EpiH16 {
    static constexpr bool PERM = true, AFTER_DRAIN = false;
    f16* O; int ld; float scale;
    __device__ __forceinline__ void operator()(const f32x4 (&acc)[2][2][4][2], const Unit& u, int wr, int wc, int fr, int fq) const {
        f16* base = O + (size_t)(u.pm * 256 + wr * 64 + fr) * ld + u.pn * 256 + wc * 32 + 8 * fq;
#pragma unroll
        for (int ai = 0; ai < 2; ++ai)
#pragma unroll
            for (int m = 0; m < 4; ++m) { f16* rowp = base + (size_t)(ai * 128 + m * 16) * ld;
#pragma unroll
                for (int bj = 0; bj < 2; ++bj) { const f32x4 v0 = acc[ai][bj][m][0] * scale, v1 = acc[ai][bj][m][1] * scale;
                    u32x4 w; w.x = pk_h2(v0[0], v0[1]); w.y = pk_h2(v0[2], v0[3]); w.z = pk_h2(v1[0], v1[1]); w.w = pk_h2(v1[2], v1[3]);
                    *(GAS u32x4*)(rowp + bj * 128) = w; } }
    }
};
struct EpiSoftmax {
    static constexpr bool PERM = true, AFTER_DRAIN = true;
    f16* P;
    __device__ __forceinline__ void fused(f32x4 (&acc)[2][2][4][2], const Unit& u, int wr, int wc, int fr, int fq, LAS unsigned char* lds, int wid, int lane) const {
        LAS float* RM = (LAS float*)lds; LAS float* RSM = (LAS float*)(lds + 4096);
#pragma unroll
        for (int ai = 0; ai < 2; ++ai)
#pragma unroll
            for (int m = 0; m < 4; ++m) { float v = -3.0e38f;
#pragma unroll
                for (int bj = 0; bj < 2; ++bj)
#pragma unroll
                    for (int n = 0; n < 2; ++n) { const f32x4 x = acc[ai][bj][m][n]; v = fmaxf(v, fmaxf(fmaxf(x[0], x[1]), fmaxf(x[2], x[3]))); }
                v = fmaxf(v, __shfl_xor(v, 16)); v = fmaxf(v, __shfl_xor(v, 32));
                if (fq == 0) RM[(ai * 128 + wr * 64 + m * 16 + fr) * 4 + wc] = v; }
        asm volatile("s_waitcnt lgkmcnt(0)" ::: "memory"); __builtin_amdgcn_s_barrier(); asm volatile("" ::: "memory");
#pragma unroll
        for (int ai = 0; ai < 2; ++ai)
#pragma unroll
            for (int m = 0; m < 4; ++m) { const f32x4 r = *(const LAS f32x4*)(RM + (ai * 128 + wr * 64 + m * 16 + fr) * 4); const float mx = fmaxf(fmaxf(r[0], r[1]), fmaxf(r[2], r[3])); float s = 0.f;
#pragma unroll
                for (int bj = 0; bj < 2; ++bj)
#pragma unroll
                    for (int n = 0; n < 2; ++n) { f32x4 x = acc[ai][bj][m][n];
#pragma unroll
                        for (int j = 0; j < 4; ++j) { x[j] = __builtin_amdgcn_exp2f(x[j] - mx); s += x[j]; }
                        acc[ai][bj][m][n] = x; }
                s += __shfl_xor(s, 16); s += __shfl_xor(s, 32);
                if (fq == 0) RSM[(ai * 128 + wr * 64 + m * 16 + fr) * 4 + wc] = s;
                asm volatile("" ::: "memory"); }
        asm volatile("s_waitcnt lgkmcnt(0)" ::: "memory"); __builtin_amdgcn_s_barrier(); asm volatile("" ::: "memory");
        f16* base = P + (size_t)(u.pm * 256 + wr * 64 + fr) * 1024 + u.pn * 256 + wc * 32 + 8 * fq;
#pragma unroll
        for (int ai = 0; ai < 2; ++ai)
#pragma unroll
            for (int m = 0; m < 4; ++m) { const f32x4 r = *(const LAS f32x4*)(RSM + (ai * 128 + wr * 64 + m * 16 + fr) * 4); const float inv = 1.0f / ((r[0] + r[1]) + (r[2] + r[3]));
                f16* rowp = base + (size_t)(ai * 128 + m * 16) * 1024;
#pragma unroll
                for (int bj = 0; bj < 2; ++bj) { const f32x4 v0 = acc[ai][bj][m][0] * inv, v1 = acc[ai][bj][m][1] * inv;
                    u32x4 w; w.x = pk_h2(v0[0], v0[1]); w.y = pk_h2(v0[2], v0[3]); w.z = pk_h2(v1[0], v1[1]); w.w = pk_h2(v1[2], v1[3]);
                    *(GAS u32x4*)(rowp + bj * 128) = w; }
                asm volatile("" ::: "memory"); }
    }
};
struct EpiHid {
    static constexpr bool PERM = true, AFTER_DRAIN = false;
    f16* HID;
    __device__ __forceinline__ void operator()(const f32x4 (&acc)[2][2][4][2], const Unit& u, int wr, int wc, int fr, int fq) const {
        f16* base = HID + (size_t)(u.z * 2048 + u.pm * 256 + wr * 64 + fr) * FF + u.pn * 128 + wc * 32 + 8 * fq;
#pragma unroll
        for (int ai = 0; ai < 2; ++ai)
#pragma unroll
            for (int m = 0; m < 4; ++m) { f32x4 h[2];
#pragma unroll
                for (int n = 0; n < 2; ++n) { const f32x4 g = acc[ai][0][m][n], up = acc[ai][1][m][n];
#pragma unroll
                    for (int j = 0; j < 4; ++j) h[n][j] = g[j] * __builtin_amdgcn_rcpf(1.0f + __builtin_amdgcn_exp2f(-g[j] * LOG2E)) * up[j]; }
                u32x4 w; w.x = pk_h2(h[0][0], h[0][1]); w.y = pk_h2(h[0][2], h[0][3]); w.z = pk_h2(h[1][0], h[1][1]); w.w = pk_h2(h[1][2], h[1][3]);
                *(GAS u32x4*)(base + (size_t)(ai * 128 + m * 16) * FF) = w; }
    }
};
struct EpiY {
    static constexpr bool PERM = true, AFTER_DRAIN = false;
    f16* Y; const float* GATE;
    __device__ __forceinline__ void operator()(const f32x4 (&acc)[2][2][4][2], const Unit& u, int wr, int wc, int fr, int fq) const {
        const int r0 = wr * 64 + fr; const float* gp = GATE + (size_t)(u.pm * NE + u.z) * CAP;
        f16* base = Y + (size_t)(u.z * 2048 + u.pm * 256 + r0) * D + u.pn * 256 + wc * 32 + 8 * fq;
#pragma unroll
        for (int ai = 0; ai < 2; ++ai)
#pragma unroll
            for (int m = 0; m < 4; ++m) { const float gt = gp[r0 + ai * 128 + m * 16]; f16* rowp = base + (size_t)(ai * 128 + m * 16) * D;
#pragma unroll
                for (int bj = 0; bj < 2; ++bj) { const f32x4 v0 = acc[ai][bj][m][0] * gt, v1 = acc[ai][bj][m][1] * gt;
                    u32x4 w; w.x = pk_h2(v0[0], v0[1]); w.y = pk_h2(v0[2], v0[3]); w.z = pk_h2(v1[0], v1[1]); w.w = pk_h2(v1[2], v1[3]);
                    *(GAS u32x4*)(rowp + bj * 128) = w; } }
    }
};

__device__ __forceinline__ void krope_pass(Frame& F) {
    const f16* HC = (const f16*)(F.ws + WS_HCAT); f16* Kb = (f16*)(F.ws + WS_K); const float* CS = (const float*)(F.ws + WS_CS);
    for (int i = (F.vcu * NTHR + F.tid); i < T * 16; i += F.G * NTHR) { const int t = i >> 4, k = i & 15;
        const float x1 = (float)HC[(size_t)t * LDH + 384 + k], x2 = (float)HC[(size_t)t * LDH + 400 + k]; const f32x2 cs = *(const GAS f32x2*)(CS + (size_t)i * 2);
        const f16 o1 = (f16)(x1 * cs.x - x2 * cs.y), o2 = (f16)(x2 * cs.x + x1 * cs.y);
#pragma unroll
        for (int h = 0; h < 8; ++h) { Kb[(size_t)t * 768 + h * 96 + 64 + k] = o1; Kb[(size_t)t * 768 + h * 96 + 80 + k] = o2; } }
}
__device__ __forceinline__ void conv_phase(KArgs ap, Frame& F) { const auto& a = *ap;
    LAS f16* GL = (LAS f16*)F.lds;
    LAS float* CO = (LAS float*)(F.lds + 62 * 512 * 2);
    const f16* HC = (const f16*)(F.ws + WS_HCAT); f16* AO = (f16*)(F.ws + WS_AO);
    const int tid = F.tid, lane = F.lane, wave = F.wave;
    float w[CW];
#pragma unroll
    for (int j = 0; j < CW; ++j) w[j] = a.conv_w[j * CCH + tid];
    const float cb = a.conv_b[tid];
    for (int tile = F.vcu; tile < T / 32; tile += F.G) {
        const int t0 = tile * 32, s0 = t0 % SEQ;
        for (int i = tid; i < 62 * 64; i += NTHR) { const int r = i >> 6, c8 = (i & 63) * 8; const int s = s0 - CPAD + r;
            u32x4 o = {0u, 0u, 0u, 0u};
            if (s >= 0 && s < SEQ) { const f16* hp = HC + (size_t)(t0 - CPAD + r) * LDH + 416 + c8;
                const f16x8 av = *(const GAS f16x8*)hp, gv = *(const GAS f16x8*)(hp + 512); float y[8];
#pragma unroll
                for (int j = 0; j < 8; ++j) { const float g = (float)gv[j]; y[j] = (float)av[j] * __builtin_amdgcn_rcpf(1.0f + __builtin_amdgcn_exp2f(-g * LOG2E)); }
                o.x = pk_h2(y[0], y[1]); o.y = pk_h2(y[2], y[3]); o.z = pk_h2(y[4], y[5]); o.w = pk_h2(y[6], y[7]); }
            *(LAS u32x4*)(GL + r * 512 + c8) = o; }
        __syncthreads();
        for (int s = 0; s < 32; ++s) { float acc = cb;
#pragma unroll
            for (int j = 0; j < CW; ++j) acc += w[j] * (float)GL[(s + j) * 512 + tid];
            CO[s * 512 + tid] = acc; }
        __syncthreads();
#pragma unroll
        for (int q = 0; q < 4; ++q) { const int s = wave * 4 + q; const LAS float* cp = CO + s * 512 + lane * 8;
            const f32x4 v0 = *(const LAS f32x4*)cp, v1 = *(const LAS f32x4*)(cp + 4);
            const float mean = wave_sum((v0[0] + v0[1]) + (v0[2] + v0[3]) + (v1[0] + v1[1]) + (v1[2] + v1[3])) * (1.0f / CCH);
            const f32x4 d0 = v0 - mean, d1 = v1 - mean;
            const float var = wave_sum((d0[0] * d0[0] + d0[1] * d0[1]) + (d0[2] * d0[2] + d0[3] * d0[3]) + (d1[0] * d1[0] + d1[1] * d1[1]) + (d1[2] * d1[2] + d1[3] * d1[3])) * (1.0f / CCH);
            const float rstd = __builtin_amdgcn_rsqf(var + EPS);
            const f32x4 g0 = *(const GAS f32x4*)(a.conv_ln_g + lane * 8), g1 = *(const GAS f32x4*)(a.conv_ln_g + lane * 8 + 4);
            const f32x4 b0 = *(const GAS f32x4*)(a.conv_ln_b + lane * 8), b1 = *(const GAS f32x4*)(a.conv_ln_b + lane * 8 + 4);
            f32x4 y0 = d0 * rstd * g0 + b0, y1 = d1 * rstd * g1 + b1;
#pragma unroll
            for (int j = 0; j < 4; ++j) { y0[j] = y0[j] * __builtin_amdgcn_rcpf(1.0f + __builtin_amdgcn_exp2f(-y0[j] * LOG2E)); y1[j] = y1[j] * __builtin_amdgcn_rcpf(1.0f + __builtin_amdgcn_exp2f(-y1[j] * LOG2E)); }
            u32x4 o; o.x = pk_h2(y0[0], y0[1]); o.y = pk_h2(y0[2], y0[3]); o.z = pk_h2(y1[0], y1[1]); o.w = pk_h2(y1[2], y1[3]);
            *(GAS u32x4*)(AO + (size_t)(t0 + s) * D + 512 + lane * 8) = o; }
        __syncthreads();
    }
}

namespace attn {
constexpr int KP = 208;
constexpr int SHM_K = 64 * KP, SHM_V = 64 * 64 * 2;
constexpr int LDS_V0 = 0, LDS_K0 = 2 * SHM_V, LDS_WS = 2 * SHM_V + 2 * SHM_K;
__device__ __forceinline__ int crow(int r, int hi) { return (r & 3) + 8 * (r >> 2) + 4 * hi; }
#define SBAR() __builtin_amdgcn_sched_barrier(0)
constexpr float THR = 8.0f * LOG2E;
__device__ __forceinline__ void partialSM(f32x16& p0, f32x16& p1, float& m_reg, float& mn, float& alpha) {
    float pmax = p0[0];
#pragma unroll
    for (int r = 1; r < 16; ++r) pmax = fmaxf(pmax, p0[r]);
#pragma unroll
    for (int r = 0; r < 16; ++r) pmax = fmaxf(pmax, p1[r]);
    { auto rr = __builtin_amdgcn_permlane32_swap(__float_as_uint(pmax), __float_as_uint(pmax), false, false); pmax = fmaxf(__uint_as_float(rr[0]), __uint_as_float(rr[1])); }
    if (__builtin_expect(__all(pmax - m_reg <= THR), 1)) { mn = m_reg; alpha = 1.f; }
    else { mn = fmaxf(m_reg, pmax); alpha = __builtin_amdgcn_exp2f(m_reg - mn); m_reg = mn; }
#pragma unroll
    for (int r = 0; r < 16; ++r) { p0[r] = p0[r] - mn; p1[r] = p1[r] - mn; }
#pragma unroll
    for (int r = 0; r < 16; ++r) p0[r] = __builtin_amdgcn_exp2f(p0[r]);
}
__device__ __forceinline__ void finishSM(f32x16& p0, f32x16& p1, float alpha, float& l_reg, f16x8& pa0, f16x8& pa1, f16x8& pa2, f16x8& pa3) {
#pragma unroll
    for (int r = 0; r < 16; ++r) p1[r] = __builtin_amdgcn_exp2f(p1[r]);
    float ps = 0;
#pragma unroll
    for (int r = 0; r < 16; ++r) ps += p0[r];
#pragma unroll
    for (int r = 0; r < 16; ++r) ps += p1[r];
    { auto rr = __builtin_amdgcn_permlane32_swap(__float_as_uint(ps), __float_as_uint(ps), false, false); ps = __uint_as_float(rr[0]) + __uint_as_float(rr[1]); }
    l_reg = l_reg * alpha + ps;
#define PK4(P, BASE, OUT) do { unsigned a0 = pk_h2(P[BASE + 0], P[BASE + 1]), a1 = pk_h2(P[BASE + 2], P[BASE + 3]);   \
    unsigned b0 = pk_h2(P[BASE + 4], P[BASE + 5]), b1 = pk_h2(P[BASE + 6], P[BASE + 7]);                              \
    auto r0 = __builtin_amdgcn_permlane32_swap(a0, b0, false, false); auto r1 = __builtin_amdgcn_permlane32_swap(a1, b1, false, false); \
    u32x4 w = {r0[0], r1[0], r0[1], r1[1]}; OUT = __builtin_bit_cast(f16x8, w); } while (0)
    PK4(p0, 0, pa0); PK4(p0, 8, pa1); PK4(p1, 0, pa2); PK4(p1, 8, pa3);
#undef PK4
}
__device__ __forceinline__ void qkt(f32x16& p0, f32x16& p1, const LAS char* Ks, const f16x8* qr, int r32, int hi) {
    p0 = f32x16{}; p1 = f32x16{};
#pragma unroll
    for (int d0 = 0; d0 < 6; ++d0) { const int cb = d0 * 32 + hi * 16;
        const f16x8 b0 = *(const LAS f16x8*)(Ks + r32 * KP + cb);
        const f16x8 b1 = *(const LAS f16x8*)(Ks + (32 + r32) * KP + cb);
        p0 = __builtin_amdgcn_mfma_f32_32x32x16_f16(b0, qr[d0], p0, 0, 0, 0);
        p1 = __builtin_amdgcn_mfma_f32_32x32x16_f16(b1, qr[d0], p1, 0, 0, 0); }
}
__device__ __forceinline__ int v_st(int k, int c) { const int kk = (k & ~0xC) | ((k & 4) << 1) | ((k & 8) >> 1); return ((kk >> 3) * 2 + (c >> 5)) * 512 + ((kk & 7) * 32 + (c & 31)) * 2; }
__device__ __forceinline__ int v_rd_base(int lane) { return ((lane & 3) << 3) | (((lane >> 2) & 3) << 6) | (((lane >> 4) & 1) << 5) | (((lane >> 5) & 1) << 8); }
constexpr int v_rd_off(int d0, int ks, int half) { return d0 * 512 + ks * 2048 + half * 1024; }
template <int OFF> __device__ __forceinline__ s16x4 tr_read(int vb) { s16x4 r; asm volatile("ds_read_b64_tr_b16 %0, %1 offset:%2" : "=&v"(r) : "v"(vb), "i"(OFF) : "memory"); return r; }
template <int D0> __device__ __forceinline__ void pv_one(f32x16& od, int vb, f16x8 pa0, f16x8 pa1, f16x8 pa2, f16x8 pa3) {
    const s16x4 l0 = tr_read<v_rd_off(D0, 0, 0)>(vb), h0 = tr_read<v_rd_off(D0, 0, 1)>(vb), l1 = tr_read<v_rd_off(D0, 1, 0)>(vb), h1 = tr_read<v_rd_off(D0, 1, 1)>(vb);
    const s16x4 l2 = tr_read<v_rd_off(D0, 2, 0)>(vb), h2 = tr_read<v_rd_off(D0, 2, 1)>(vb), l3 = tr_read<v_rd_off(D0, 3, 0)>(vb), h3 = tr_read<v_rd_off(D0, 3, 1)>(vb);
    asm volatile("s_waitcnt lgkmcnt(0)" ::: "memory"); SBAR();
#define PKV(L, H) __builtin_bit_cast(f16x8, (u32x4){__builtin_bit_cast(u32x2, L)[0], __builtin_bit_cast(u32x2, L)[1], __builtin_bit_cast(u32x2, H)[0], __builtin_bit_cast(u32x2, H)[1]})
    od = __builtin_amdgcn_mfma_f32_32x32x16_f16(pa0, PKV(l0, h0), od, 0, 0, 0);
    od = __builtin_amdgcn_mfma_f32_32x32x16_f16(pa1, PKV(l1, h1), od, 0, 0, 0);
    od = __builtin_amdgcn_mfma_f32_32x32x16_f16(pa2, PKV(l2, h2), od, 0, 0, 0);
    od = __builtin_amdgcn_mfma_f32_32x32x16_f16(pa3, PKV(l3, h3), od, 0, 0, 0);
#undef PKV
}
__device__ __forceinline__ void unit(const f16* __restrict__ Qb, const f16* __restrict__ Kh, const f16* __restrict__ Vh, f16* __restrict__ Ob, LAS char* lds) {
    const int tid = opaque_tid(), wid = __builtin_amdgcn_readfirstlane(tid >> 6), lane = tid & 63, r32 = lane & 31, hi = lane >> 5;
    LAS char* V_lds = lds + LDS_V0; LAS char* K_lds = lds + LDS_K0;
    LAS float* ws = (LAS float*)(lds + LDS_WS) + wid * 64; LAS float* li_l = ws; LAS float* al_l = ws + 32;
    float m_reg = -1e30f, l_reg = 0; f32x16 o[2] = {}; f16x8 qr[6];
    const f16* Qw = Qb + (size_t)(wid * 32 + r32) * 768 + hi * 8;
#pragma unroll
    for (int d0 = 0; d0 < 6; ++d0) qr[d0] = *(const GAS f16x8*)(Qw + d0 * 16);
    const int vr = tid >> 3, vc = (tid & 7) * 8, vst = v_st(vr, vc);
    const int kr0 = tid / 12, kc0 = tid % 12, kr1 = (512 + tid) / 12, kc1 = (512 + tid) % 12; const bool k2 = tid < 256;
    const int kst0 = kr0 * KP + kc0 * 16, kst1 = kr1 * KP + kc1 * 16;
    const int vb0 = (int)(uintptr_t)V_lds + v_rd_base(lane);
    struct { f16x8 vs, ks0, ks1; } sr_[2];
#define SLOAD(i, k0) do { sr_[i].vs = *(const GAS f16x8*)(Vh + (size_t)((k0) + vr) * 512 + vc); sr_[i].ks0 = *(const GAS f16x8*)(Kh + (size_t)((k0) + kr0) * 768 + kc0 * 8); \
    if (k2) sr_[i].ks1 = *(const GAS f16x8*)(Kh + (size_t)((k0) + kr1) * 768 + kc1 * 8); } while (0)
#define SWRITE(b, i) do { *(LAS f16x8*)(V_lds + (b) * SHM_V + vst) = sr_[i].vs; *(LAS f16x8*)(K_lds + (b) * SHM_K + kst0) = sr_[i].ks0; \
    if (k2) *(LAS f16x8*)(K_lds + (b) * SHM_K + kst1) = sr_[i].ks1; } while (0)
#define RESC(a) do { if (__any((a) < 1.f)) { if (hi == 0) al_l[r32] = (a); asm volatile("s_waitcnt lgkmcnt(0)" ::: "memory"); \
    _Pragma("unroll") for (int d = 0; d < 2; ++d) _Pragma("unroll") for (int r = 0; r < 16; ++r) o[d][r] *= al_l[crow(r, hi)]; } } while (0)
    f32x16 pA0, pA1, pB0, pB1; float mnA, mnB, alA, alB; f16x8 pa0, pa1, pa2, pa3; constexpr int NT = SEQ / 64;
    SLOAD(0, 0); asm volatile("s_waitcnt vmcnt(0)" ::: "memory"); SWRITE(0, 0); __syncthreads();
    qkt(pA0, pA1, K_lds, qr, r32, hi); partialSM(pA0, pA1, m_reg, mnA, alA);
    SLOAD(1, 64); SLOAD(0, 128);
    asm volatile("s_waitcnt vmcnt(3)" ::: "memory"); SWRITE(1, 1); __syncthreads();
    for (int j = 1; j + 1 < NT; j += 2) {
        SBAR(); qkt(pB0, pB1, K_lds + SHM_K, qr, r32, hi);
        finishSM(pA0, pA1, alA, l_reg, pa0, pa1, pa2, pa3); SBAR();
        SLOAD(1, (j + 2) * 64); SBAR();
        pv_one<0>(o[0], vb0, pa0, pa1, pa2, pa3); pv_one<1>(o[1], vb0, pa0, pa1, pa2, pa3); partialSM(pB0, pB1, m_reg, mnB, alB);
        __syncthreads(); asm volatile("s_waitcnt vmcnt(3)" ::: "memory"); SWRITE(0, 0);
        RESC(alB); __syncthreads();
        SBAR(); qkt(pA0, pA1, K_lds, qr, r32, hi);
        finishSM(pB0, pB1, alB, l_reg, pa0, pa1, pa2, pa3); SBAR();
        if (j + 3 < NT) SLOAD(0, (j + 3) * 64); SBAR();
        pv_one<0>(o[0], vb0 + SHM_V, pa0, pa1, pa2, pa3); pv_one<1>(o[1], vb0 + SHM_V, pa0, pa1, pa2, pa3); partialSM(pA0, pA1, m_reg, mnA, alA);
        __syncthreads(); asm volatile("s_waitcnt vmcnt(3)" ::: "memory"); SWRITE(1, 1);
        RESC(alA); __syncthreads();
    }
    SBAR(); qkt(pB0, pB1, K_lds + SHM_K, qr, r32, hi);
    finishSM(pA0, pA1, alA, l_reg, pa0, pa1, pa2, pa3); SBAR();
    pv_one<0>(o[0], vb0, pa0, pa1, pa2, pa3); pv_one<1>(o[1], vb0, pa0, pa1, pa2, pa3); partialSM(pB0, pB1, m_reg, mnB, alB);
    __syncthreads(); RESC(alB);
    finishSM(pB0, pB1, alB, l_reg, pa0, pa1, pa2, pa3); SBAR();
    pv_one<0>(o[0], vb0 + SHM_V, pa0, pa1, pa2, pa3); pv_one<1>(o[1], vb0 + SHM_V, pa0, pa1, pa2, pa3);
    if (hi == 0) li_l[r32] = l_reg; asm volatile("s_waitcnt lgkmcnt(0)" ::: "memory");
    float rli[16];
#pragma unroll
    for (int r = 0; r < 16; ++r) rli[r] = __builtin_amdgcn_rcpf(li_l[crow(r, hi)]);
    f16* Ow = Ob + (size_t)(wid * 32) * 1024;
#pragma unroll
    for (int r = 0; r < 16; ++r) { const int orow = crow(r, hi);
#pragma unroll
        for (int d0 = 0; d0 < 2; ++d0) Ow[(size_t)orow * 1024 + d0 * 32 + r32] = (f16)(o[d0][r] * rli[r]); }
    __syncthreads();
#undef SLOAD
#undef SWRITE
#undef RESC
}
__device__ __forceinline__ void unit_naive(const f16* Qb, const f16* Kh, const f16* Vh, f16* Ob) {
    const int tid = opaque_tid(); if (tid >= 256) return;
    float q[96], o[64], m = -1e30f, l = 0.f;
#pragma unroll
    for (int d = 0; d < 96; ++d) q[d] = (float)Qb[(size_t)tid * 768 + d];
#pragma unroll
    for (int d = 0; d < 64; ++d) o[d] = 0.f;
    for (int k = 0; k < SEQ; ++k) { float s = 0.f;
#pragma unroll
        for (int d = 0; d < 96; ++d) s += q[d] * (float)Kh[(size_t)k * 768 + d];
        const float mn = fmaxf(m, s), al = __builtin_amdgcn_exp2f(m - mn), p = __builtin_amdgcn_exp2f(s - mn); m = mn; l = l * al + p;
#pragma unroll
        for (int d = 0; d < 64; ++d) o[d] = o[d] * al + p * (float)Vh[(size_t)k * 512 + d]; }
    const float inv = 1.0f / l;
#pragma unroll
    for (int d = 0; d < 64; ++d) Ob[(size_t)tid * 1024 + d] = (f16)(o[d] * inv);
}
#undef SBAR
}

__device__ __forceinline__ void attn_phase(Frame& F) {
    const f16* Q = (const f16*)(F.ws + WS_Q); const f16* Kb = (const f16*)(F.ws + WS_K); const f16* V = (const f16*)(F.ws + WS_V); f16* AO = (f16*)(F.ws + WS_AO);
    for (int L = F.vcu; L < NB * 8 * 8; L += F.G) { const int bh = L >> 3, qb = L & 7, b = bh >> 3, h = bh & 7;
        const size_t r0 = (size_t)b * SEQ;
#if NAIVE_ATTN
        attn::unit_naive(Q + (r0 + qb * 256) * 768 + h * 96, Kb + r0 * 768 + h * 96, V + r0 * 512 + h * 64, AO + (r0 + qb * 256) * 1024 + h * 64);
#else
        attn::unit(Q + (r0 + qb * 256) * 768 + h * 96, Kb + r0 * 768 + h * 96, V + r0 * 512 + h * 64, AO + (r0 + qb * 256) * 1024 + h * 64, (LAS char*)F.lds);
#endif
    }
}

__device__ __forceinline__ void ln_rows(Frame& F, const float* PRE, const float* g, const float* b, float* H, f16* HH) {
    const int gw = F.vcu * NWAVES + F.wave, NGW = F.G * NWAVES, lane = F.lane;
    f32x4 gv[4], bv[4];
#pragma unroll
    for (int j = 0; j < 4; ++j) { gv[j] = *(const GAS f32x4*)(g + 4 * lane + 256 * j); bv[j] = *(const GAS f32x4*)(b + 4 * lane + 256 * j); }
    for (int row = gw; row < T; row += NGW) { const float* pr = PRE + (size_t)row * D + 4 * lane; f32x4 v[4]; float s = 0.f;
#pragma unroll
        for (int j = 0; j < 4; ++j) { v[j] = *(const GAS f32x4*)(pr + 256 * j); s += (v[j][0] + v[j][1]) + (v[j][2] + v[j][3]); }
        const float mean = wave_sum(s) * (1.0f / D); float s2 = 0.f;
#pragma unroll
        for (int j = 0; j < 4; ++j) { v[j] = v[j] - mean; s2 += (v[j][0] * v[j][0] + v[j][1] * v[j][1]) + (v[j][2] * v[j][2] + v[j][3] * v[j][3]); }
        const float rstd = __builtin_amdgcn_rsqf(wave_sum(s2) * (1.0f / D) + EPS);
#pragma unroll
        for (int j = 0; j < 4; ++j) { const f32x4 y = v[j] * rstd * gv[j] + bv[j];
            *(GAS f32x4*)(H + (size_t)row * D + 4 * lane + 256 * j) = y;
            *(GAS u32x2*)(HH + (size_t)row * D + 4 * lane + 256 * j) = (u32x2){pk_h2(y[0], y[1]), pk_h2(y[2], y[3])}; } }
}
__device__ __forceinline__ void ln2_router(KArgs ap, Frame& F) { const auto& a = *ap;
    const float* PRE = (const float*)(F.ws + WS_PRE); float* H = (float*)(F.ws + WS_HA); f16* HH = (f16*)(F.ws + WS_HH); float* AFF = (float*)(F.ws + WS_AFF);
    const int gw = F.vcu * NWAVES + F.wave, NGW = F.G * NWAVES, lane = F.lane;
    for (int r0 = gw * 2; r0 < T; r0 += NGW * 2) {
        f32x4 y[2][4];
#pragma unroll
        for (int q = 0; q < 2; ++q) { const float* pr = PRE + (size_t)(r0 + q) * D + 4 * lane; float s = 0.f;
#pragma unroll
            for (int j = 0; j < 4; ++j) { y[q][j] = *(const GAS f32x4*)(pr + 256 * j); s += (y[q][j][0] + y[q][j][1]) + (y[q][j][2] + y[q][j][3]); }
            const float mean = wave_sum(s) * (1.0f / D); float s2 = 0.f;
#pragma unroll
            for (int j = 0; j < 4; ++j) { y[q][j] = y[q][j] - mean; s2 += (y[q][j][0] * y[q][j][0] + y[q][j][1] * y[q][j][1]) + (y[q][j][2] * y[q][j][2] + y[q][j][3] * y[q][j][3]); }
            const float rstd = __builtin_amdgcn_rsqf(wave_sum(s2) * (1.0f / D) + EPS);
#pragma unroll
            for (int j = 0; j < 4; ++j) { const f32x4 gv = *(const GAS f32x4*)(a.ln2_g + 4 * lane + 256 * j), bv = *(const GAS f32x4*)(a.ln2_b + 4 * lane + 256 * j);
                y[q][j] = y[q][j] * rstd * gv + bv;
                *(GAS f32x4*)(H + (size_t)(r0 + q) * D + 4 * lane + 256 * j) = y[q][j];
                *(GAS u32x2*)(HH + (size_t)(r0 + q) * D + 4 * lane + 256 * j) = (u32x2){pk_h2(y[q][j][0], y[q][j][1]), pk_h2(y[q][j][2], y[q][j][3])}; }
            asm volatile("" ::: "memory"); }
        float part[32];
#pragma unroll
        for (int k = 0; k < 32; ++k) part[k] = 0.f;
        const float* wrow = a.w_router + (size_t)(4 * lane) * NE;
#pragma unroll
        for (int j = 0; j < 4; ++j) { asm volatile("" : "+v"(wrow));
#pragma unroll
            for (int cc = 0; cc < 4; ++cc) { const float* wp = wrow + cc * NE;
                const f32x4 w0 = *(const GAS f32x4*)wp, w1 = *(const GAS f32x4*)(wp + 4), w2 = *(const GAS f32x4*)(wp + 8), w3 = *(const GAS f32x4*)(wp + 12);
#pragma unroll
                for (int q = 0; q < 2; ++q) { const float hv = y[q][j][cc];
#pragma unroll
                    for (int e = 0; e < 4; ++e) { part[q * 16 + e] += hv * w0[e]; part[q * 16 + 4 + e] += hv * w1[e]; part[q * 16 + 8 + e] += hv * w2[e]; part[q * 16 + 12 + e] += hv * w3[e]; } } }
            wrow += 256 * NE; asm volatile("" ::: "memory"); }
#define RSTEP(N, BIT) _Pragma("unroll") for (int k = 0; k < N; ++k) { const bool up = (lane >> BIT) & 1; const float send = up ? part[k] : part[k + N], keep = up ? part[k + N] : part[k]; part[k] = keep + __shfl_xor(send, 1 << BIT); }
        RSTEP(16, 4) RSTEP(8, 3) RSTEP(4, 2) RSTEP(2, 1) RSTEP(1, 0)
#undef RSTEP
        float lg = part[0] + __shfl_xor(part[0], 32), mx = lg;
#pragma unroll
        for (int o = 1; o < 16; o <<= 1) mx = fmaxf(mx, __shfl_xor(mx, o));
        const float p = __builtin_amdgcn_exp2f((lg - mx) * LOG2E); float sm = p;
#pragma unroll
        for (int o = 1; o < 16; o <<= 1) sm += __shfl_xor(sm, o);
        if (lane < 32) AFF[(size_t)r0 * NE + lane] = p / sm;
    }
}
__device__ __forceinline__ void topk_phase(Frame& F) {
    LAS unsigned* cnt = (LAS unsigned*)F.lds;
    LAS unsigned* wtot = (LAS unsigned*)(F.lds + 256);
    LAS int* lst = (LAS int*)(F.lds + 1024);
    const float* AFF = (const float*)(F.ws + WS_AFF); float* GATE = (float*)(F.ws + WS_GATE); int* SLOT = (int*)(F.ws + WS_SLOT);
    const f16* HH = (const f16*)(F.ws + WS_HH); f16* XS = (f16*)(F.ws + WS_XS);
    const int lane = F.lane, wave = F.wave;
    for (int item = F.vcu; item < NB * NE * 2; item += F.G) { const int half = item & 1, e = (item >> 1) & 15, b = item >> 5;
        float val[4]; unsigned key[4];
#pragma unroll
        for (int k = 0; k < 4; ++k) { val[k] = AFF[(size_t)(b * SEQ + wave * 256 + k * 64 + lane) * NE + e]; key[k] = __float_as_uint(val[k]); }
        unsigned t = 0u;
        for (int bit = 30; bit >= 0; --bit) { const unsigned cand = t | (1u << bit); unsigned c = 0u;
#pragma unroll
            for (int k = 0; k < 4; ++k) c += (unsigned)__builtin_popcountll(__ballot(key[k] >= cand));
            if (lane == 0) cnt[(bit & 1) * 8 + wave] = c;
            asm volatile("s_waitcnt lgkmcnt(0)" ::: "memory"); __builtin_amdgcn_s_barrier(); asm volatile("" ::: "memory");
            const u32x4 c0 = *(const LAS u32x4*)(cnt + (bit & 1) * 8), c1 = *(const LAS u32x4*)(cnt + (bit & 1) * 8 + 4);
            const unsigned tot = (c0[0] + c0[1]) + (c0[2] + c0[3]) + (c1[0] + c1[1]) + (c1[2] + c1[3]);
            if (tot >= (unsigned)CAP) t = cand; }
        unsigned long long bg[4], be[4]; unsigned tg = 0u, te = 0u;
#pragma unroll
        for (int k = 0; k < 4; ++k) { bg[k] = __ballot(key[k] > t); be[k] = __ballot(key[k] == t); tg += (unsigned)__builtin_popcountll(bg[k]); te += (unsigned)__builtin_popcountll(be[k]); }
        if (lane == 0) { wtot[wave * 2] = tg; wtot[wave * 2 + 1] = te; }
        asm volatile("s_waitcnt lgkmcnt(0)" ::: "memory"); __builtin_amdgcn_s_barrier(); asm volatile("" ::: "memory");
        unsigned gbase = 0u, ebase = 0u, gall = 0u;
#pragma unroll
        for (int w = 0; w < 8; ++w) { const unsigned a = wtot[w * 2], q = wtot[w * 2 + 1]; gall += a; if (w < wave) { gbase += a; ebase += q; } }
        const unsigned need = (unsigned)CAP - gall;
        const unsigned long long below = (1ull << lane) - 1ull;
#pragma unroll
        for (int k = 0; k < 4; ++k) { const int i = wave * 256 + k * 64 + lane;
            const unsigned gb = gbase + (unsigned)__builtin_popcountll(bg[k] & below), eb = ebase + (unsigned)__builtin_popcountll(be[k] & below);
            const bool isg = (bg[k] >> lane) & 1ull, ise = (be[k] >> lane) & 1ull;
            const bool sel = isg || (ise && eb < need); const unsigned slot = gb + (eb < need ? eb : need);
            if (half == 0) SLOT[(size_t)(b * SEQ + i) * NE + e] = sel ? (int)slot : -1;
            if (sel) { lst[slot] = i; if (half == 0) GATE[(size_t)(b * NE + e) * CAP + slot] = val[k]; }
            gbase += (unsigned)__builtin_popcountll(bg[k]); ebase += (unsigned)__builtin_popcountll(be[k]); }
        asm volatile("s_waitcnt lgkmcnt(0)" ::: "memory"); __builtin_amdgcn_s_barrier(); asm volatile("" ::: "memory");
#pragma unroll 1
        for (int q = 0; q < 16; q += 4) { u32x4 p[4][2]; int r[4];
#pragma unroll
            for (int j = 0; j < 4; ++j) { r[j] = half * 128 + wave * 16 + q + j; const f16* src = HH + (size_t)(b * SEQ + lst[r[j]]) * D;
                p[j][0] = *(const GAS u32x4*)(src + lane * 8); p[j][1] = *(const GAS u32x4*)(src + 512 + lane * 8); }
#pragma unroll
            for (int j = 0; j < 4; ++j) { f16* dst = XS + ((size_t)e * 2048 + b * CAP + r[j]) * D;
                *(GAS u32x4*)(dst + lane * 8) = p[j][0]; *(GAS u32x4*)(dst + 512 + lane * 8) = p[j][1]; } }
        asm volatile("s_waitcnt lgkmcnt(0)" ::: "memory"); __builtin_amdgcn_s_barrier(); asm volatile("" ::: "memory");
    }
}
__device__ __forceinline__ void combine_ln3(KArgs ap, Frame& F) { const auto& a = *ap;
    const float* H = (const float*)(F.ws + WS_HA); const f16* Y = (const f16*)(F.ws + WS_Y); const int* SLOT = (const int*)(F.ws + WS_SLOT);
    const int gw = F.vcu * NWAVES + F.wave, NGW = F.G * NWAVES, lane = F.lane;
    f32x4 gv[4], bv[4];
#pragma unroll
    for (int j = 0; j < 4; ++j) { gv[j] = *(const GAS f32x4*)(a.ln3_g + 4 * lane + 256 * j); bv[j] = *(const GAS f32x4*)(a.ln3_b + 4 * lane + 256 * j); }
    for (int row = gw; row < T; row += NGW) { const int b = row / SEQ; f32x4 v[4];
#pragma unroll
        for (int j = 0; j < 4; ++j) v[j] = *(const GAS f32x4*)(H + (size_t)row * D + 4 * lane + 256 * j) * ALPHA;
        const int sl = (lane < NE) ? SLOT[(size_t)row * NE + lane] : -1;
        for (int e = 0; e < NE; ++e) { const int s = __builtin_amdgcn_readlane(sl, e); if (s < 0) continue;
            const f16* yp = Y + ((size_t)e * 2048 + b * CAP + s) * D + 4 * lane;
#pragma unroll
            for (int j = 0; j < 4; ++j) { const f16x4 yv = *(const GAS f16x4*)(yp + 256 * j); v[j] += (f32x4){(float)yv[0], (float)yv[1], (float)yv[2], (float)yv[3]}; } }
        float s = 0.f;
#pragma unroll
        for (int j = 0; j < 4; ++j) s += (v[j][0] + v[j][1]) + (v[j][2] + v[j][3]);
        const float mean = wave_sum(s) * (1.0f / D); float s2 = 0.f;
#pragma unroll
        for (int j = 0; j < 4; ++j) { v[j] = v[j] - mean; s2 += (v[j][0] * v[j][0] + v[j][1] * v[j][1]) + (v[j][2] * v[j][2] + v[j][3] * v[j][3]); }
        const float rstd = __builtin_amdgcn_rsqf(wave_sum(s2) * (1.0f / D) + EPS);
#pragma unroll
        for (int j = 0; j < 4; ++j) *(GAS f32x4*)(a.out + (size_t)row * D + 4 * lane + 256 * j) = v[j] * rstd * gv[j] + bv[j];
    }
}

constexpr int NPHASE = 14;
__global__ void __launch_bounds__(NTHR, 2) fwd(Args args) {
    extern __shared__ __attribute__((aligned(16))) unsigned char lds_raw[];
    Frame F; F.lds = (LAS unsigned char*)lds_raw; F.tid = threadIdx.x; F.lane = F.tid & 63; F.wave = __builtin_amdgcn_readfirstlane(F.tid >> 6);
    F.G = gridDim.x; { const int bx = blockIdx.x; F.vcu = (F.G % 8 == 0) ? (bx % 8) * (F.G / 8) + bx / 8 : bx; }
    KArgs kp = (KArgs)__builtin_amdgcn_kernarg_segment_ptr();
#define KP() ({ KArgs p_ = kp; asm volatile("" : "+s"(p_)); p_; })
    F.ws = kp->ws;
    unsigned char* ws = F.ws;
    volatile LAS unsigned* MISC = (volatile LAS unsigned*)(F.lds + MISC_OFF);
    for (int u = F.tid; u < (LDS_BYTES - RING_BYTES) / 4; u += NTHR) ((LAS unsigned*)(F.lds + RING_BYTES))[u] = 0u;
    __syncthreads();
    const int lo = kp->ph_lo, hi = kp->ph_hi;
    XcdBarrier bar; bar.bar = (unsigned*)(ws + WS_CTL) + CW_BAR; bar.x = 0; bar.st = nullptr;
    if (hi - lo > 1) bar = xcd_barrier_post((unsigned*)(ws + WS_CTL) + CW_BAR, MISC + 8);
#ifdef ONLY_PH
#define IN(k) ((k) == ONLY_PH && lo <= (k) && (k) < hi)
#else
#define IN(k) (lo <= (k) && (k) < hi)
#endif
#define REPS(k) for (int rep_ = 0; rep_ <= ((DUP_MASK >> (k)) & 1); ++rep_)
#define SEAM(k) do { if (IN(k) && IN((k) + 1)) xcd_barrier(bar); } while (0)
    const char* wsc = (const char*)ws;
    float* RS = (float*)(ws + WS_CTL) + CW_RS;

    if (IN(0)) REPS(0) { frame_ids(F); p0_prologue(KP(), F); } SEAM(0);

    if (IN(1)) REPS(1) { frame_ids(F);
        SchedG1 S{F.vcu, F.G, wsc + WS_XH, wsc + WS_WIN, wsc + WS_MEMH, wsc + WS_XWK, wsc + WS_XWV};
        EpiG1 E{(f16*)(ws + WS_HCAT), (f16*)(ws + WS_MK), (f16*)(ws + WS_MVT), rep_ ? (float*)(ws + 30 * MiB) : RS};
        pg8::gemm_phase<EpiG1, SchedG1, true>(F.lds, pg8::Gemm{1024, 1024, 1024}, S, E);
    } SEAM(1);

    if (IN(2)) REPS(2) { frame_ids(F);
        SchedGrid S{F.vcu, F.G, 7, 448, wsc + WS_HCAT, wsc + WS_WUP, (size_t)256 * LDH * 2, (size_t)256 * 384 * 2};
        EpiUP E{(f16*)(ws + WS_Q), (f16*)(ws + WS_K), (f16*)(ws + WS_V), RS, (const float*)(ws + WS_CS)};
        pg8::gemm_phase<EpiUP, SchedGrid, true>(F.lds, pg8::Gemm{LDH, 384, 384}, S, E);
        krope_pass(F);
        conv_phase(KP(), F);
    } SEAM(2);

    if (IN(3)) REPS(3) { frame_ids(F); attn_phase(F); } SEAM(3);

    if (IN(4)) REPS(4) { frame_ids(F);
        SchedGrid S{F.vcu, F.G, 4, 256, wsc + WS_AO, wsc + WS_WO, (size_t)256 * 1024 * 2, (size_t)256 * 1024 * 2};
        EpiPre E{KP()->x, (float*)(ws + WS_PRE)};
        pg8::gemm_phase<EpiPre, SchedGrid, true>(F.lds, pg8::Gemm{1024, 1024, 1024}, S, E);
    } SEAM(4);

    if (IN(5)) REPS(5) { frame_ids(F); ln_rows(F, (const float*)(ws + WS_PRE), KP()->ln1_g, KP()->ln1_b, (float*)(ws + WS_HA), (f16*)(ws + WS_HH)); } SEAM(5);

    if (IN(6)) REPS(6) { frame_ids(F);
        SchedGrid S{F.vcu, F.G, 4, 256, wsc + WS_HH, wsc + WS_XWQ, (size_t)256 * 1024 * 2, (size_t)256 * 1024 * 2};
        EpiH16 E{(f16*)(ws + WS_XQ), 1024, XSCALE};
        pg8::gemm_phase<EpiH16, SchedGrid, true>(F.lds, pg8::Gemm{1024, 1024, 1024}, S, E);
    } SEAM(6);

    if (IN(7)) REPS(7) { frame_ids(F);
        { SchedXS S{F.vcu, F.G, wsc + WS_XQ, wsc + WS_MK, 0}; EpiSoftmax E{(f16*)(ws + WS_P)};
          pg8::gemm_phase<EpiSoftmax, SchedXS, false>(F.lds, pg8::Gemm{1024, 1024, 256}, S, E); }
        VM_WAIT(); __syncthreads();
        { SchedXS S{F.vcu, F.G, wsc + WS_P, wsc + WS_MVT, 1}; EpiH16 E{(f16*)(ws + WS_XO), 1024, 1.0f};
          pg8::gemm_phase<EpiH16, SchedXS, true>(F.lds, pg8::Gemm{1024, MT, 256}, S, E); }
    } SEAM(7);

    if (IN(8)) REPS(8) { frame_ids(F);
        SchedGrid S{F.vcu, F.G, 4, 256, wsc + WS_XO, wsc + WS_XWO, (size_t)256 * 1024 * 2, (size_t)256 * 1024 * 2};
        EpiPre E{(const float*)(ws + WS_HA), (float*)(ws + WS_PRE)};
        pg8::gemm_phase<EpiPre, SchedGrid, true>(F.lds, pg8::Gemm{1024, 1024, 1024}, S, E);
    } SEAM(8);

    if (IN(9)) REPS(9) { frame_ids(F); ln2_router(KP(), F); } SEAM(9);

    if (IN(10)) REPS(10) { frame_ids(F); topk_phase(F); } SEAM(10);

    if (IN(11)) REPS(11) { frame_ids(F);
        SchedMoE S{F.vcu, F.G, 16, 2048, wsc + WS_XS, wsc + WS_WGU, (size_t)2048 * 1024 * 2, (size_t)4096 * 1024 * 2, (size_t)256 * 1024 * 2, (size_t)256 * 1024 * 2};
        EpiHid E{(f16*)(ws + WS_HID)};
        pg8::gemm_phase<EpiHid, SchedMoE, true>(F.lds, pg8::Gemm{1024, 1024, 1024}, S, E);
    } SEAM(11);

    if (IN(12)) REPS(12) { frame_ids(F);
        SchedMoE S{F.vcu, F.G, 4, 512, wsc + WS_HID, wsc + WS_WD, (size_t)2048 * 2048 * 2, (size_t)1024 * 2048 * 2, (size_t)256 * 2048 * 2, (size_t)256 * 2048 * 2};
        EpiY E{(f16*)(ws + WS_Y), (const float*)(ws + WS_GATE)};
        pg8::gemm_phase<EpiY, SchedMoE, true>(F.lds, pg8::Gemm{2048, 2048, 2048}, S, E);
    } SEAM(12);

    if (IN(13)) REPS(13) { frame_ids(F); combine_ln3(KP(), F); }
#undef IN
#undef SEAM
}

extern "C" void kernel_launch(void* const* d_in, const int* in_sizes, int n_in, void* d_out, int out_size, void* d_ws, size_t ws_size, hipStream_t stream) {
    static int ok = 0;
    if (ok == 0) {
        if (n_in != 28 || in_sizes[0] != T * D || out_size != T * D || ws_size < WS_END) {
            fprintf(stderr, "kernel_launch: shape mismatch: n_in %d in0 %d out %d ws %zu (need %zu)\n", n_in, n_in > 0 ? in_sizes[0] : -1, out_size, ws_size, (size_t)WS_END); ok = -1; return; }
        if (hipFuncSetAttribute((const void*)fwd, hipFuncAttributeMaxDynamicSharedMemorySize, LDS_BYTES) != hipSuccess) { fprintf(stderr, "kernel_launch: hipFuncSetAttribute failed\n"); ok = -1; return; }
        int per_cu = 0;
        if (hipOccupancyMaxActiveBlocksPerMultiprocessor(&per_cu, (const void*)fwd, NTHR, LDS_BYTES) != hipSuccess || per_cu < 1) fprintf(stderr, "kernel_launch: occupancy query reports %d blocks per CU\n", per_cu);
        (void)hipGetLastError();
        ok = 1;
    }
    if (ok < 0) return;
    (void)hipMemsetAsync((char*)d_ws + WS_CTL, 0, CTL_BYTES, stream);
    Args a{};
    a.x = (const float*)d_in[0]; a.mem = (const float*)d_in[1]; a.pos = (const int*)d_in[2]; a.w_in = (const float*)d_in[3]; a.q_norm_g = (const float*)d_in[4]; a.w_uq = (const float*)d_in[5];
    a.kv_norm_g = (const float*)d_in[6]; a.w_uk = (const float*)d_in[7]; a.w_uv = (const float*)d_in[8]; a.conv_w = (const float*)d_in[9]; a.conv_b = (const float*)d_in[10];
    a.conv_ln_g = (const float*)d_in[11]; a.conv_ln_b = (const float*)d_in[12]; a.w_o = (const float*)d_in[13]; a.ln1_g = (const float*)d_in[14]; a.ln1_b = (const float*)d_in[15];
    a.xa_w_q = (const float*)d_in[16]; a.xa_w_k = (const float*)d_in[17]; a.xa_w_v = (const float*)d_in[18]; a.xa_w_o = (const float*)d_in[19]; a.ln2_g = (const float*)d_in[20]; a.ln2_b = (const float*)d_in[21];
    a.w_router = (const float*)d_in[22]; a.w_gate = (const float*)d_in[23]; a.w_up = (const float*)d_in[24]; a.w_down = (const float*)d_in[25]; a.ln3_g = (const float*)d_in[26]; a.ln3_b = (const float*)d_in[27];
    a.out = (float*)d_out; a.ws = (unsigned char*)d_ws;
    for (int i = 0; i < 16; ++i) a.invf[i] = powf(10000.0f, -(float)(2 * i) / 32.0f);
#if MK_N_LAUNCHES == 1
    a.ph_lo = 0; a.ph_hi = NPHASE;
    hipLaunchKernelGGL(fwd, dim3(GRID), dim3(NTHR), LDS_BYTES, stream, a);
#else
    for (int p = 0; p < NPHASE; ++p) { a.ph_lo = p; a.ph_hi = p + 1; hipLaunchKernelGGL(fwd, dim3(GRID), dim3(NTHR), LDS_BYTES, stream, a); }
#endif
    const hipError_t le = hipPeekAtLastError();
    if (le != hipSuccess) fprintf(stderr, "kernel_launch: launch failed: %s\n", hipGetErrorName(le));
}
```

```cpp
#include <hip/hip_runtime.h>
#include <cstdio>
#include <cstdint>
#include <cmath>

#define LAS __attribute__((address_space(3)))
#define GAS __attribute__((address_space(1)))
typedef _Float16 f16;
typedef _Float16 f16x2 __attribute__((ext_vector_type(2)));
typedef _Float16 f16x4 __attribute__((ext_vector_type(4)));
typedef _Float16 f16x8 __attribute__((ext_vector_type(8)));
typedef float f32x2 __attribute__((ext_vector_type(2)));
typedef float f32x4 __attribute__((ext_vector_type(4)));
typedef float f32x16 __attribute__((ext_vector_type(16)));
typedef unsigned u32x2 __attribute__((ext_vector_type(2)));
typedef unsigned u32x4 __attribute__((ext_vector_type(4)));
typedef short s16x4 __attribute__((ext_vector_type(4)));
typedef GAS unsigned gu32;

#ifndef MK_N_LAUNCHES
#define MK_N_LAUNCHES 1
#endif
#ifndef DUP_MASK
#define DUP_MASK 0
#endif
#ifndef NAIVE_ATTN
#define NAIVE_ATTN 0
#endif

constexpr int NB = 8, SEQ = 2048, T = NB * SEQ, D = 1024;
constexpr int LDH = 1536;
constexpr int MEML = 256, MT = NB * MEML;
constexpr int NE = 16, FF = 2048, CAP = 256;
constexpr int CCH = 512, CW = 31, CPAD = 15;
constexpr float EPS = 1e-5f;
constexpr float ALPHA = 1.189207115002721f;
constexpr float LOG2E = 1.4426950408889634f;
constexpr float QSCALE = LOG2E * 0.10206207261596577f;
constexpr float XSCALE = LOG2E / 16.0f;
constexpr int NWAVES = 8, NTHR = 512, GRID = 256;

constexpr size_t MiB = 1ull << 20;
constexpr size_t WS_CTL = 0, CTL_BYTES = MiB;
constexpr size_t WS_WIN = 1 * MiB, WS_WUP = 4 * MiB, WS_WO = 6 * MiB, WS_XWQ = 8 * MiB, WS_XWK = 10 * MiB, WS_XWV = 12 * MiB, WS_XWO = 14 * MiB;
constexpr size_t WS_CS = 16 * MiB, WS_AFF = 19 * MiB, WS_SLOT = 20 * MiB, WS_TOK = 21 * MiB, WS_GATE = 21 * MiB + 512 * 1024, WS_MK = 22 * MiB, WS_MVT = 26 * MiB;
constexpr size_t WS_WGU = 32 * MiB, WS_WD = 160 * MiB;
constexpr size_t WS_XH = 288 * MiB, WS_MEMH = 320 * MiB, WS_HCAT = 324 * MiB, WS_Q = 372 * MiB, WS_K = 396 * MiB, WS_V = 420 * MiB, WS_AO = 436 * MiB;
constexpr size_t WS_PRE = 224 * MiB, WS_HH = 352 * MiB, WS_XQ = 384 * MiB, WS_P = 416 * MiB, WS_XO = 448 * MiB;
constexpr size_t WS_XS = 288 * MiB, WS_HID = 384 * MiB, WS_Y = 32 * MiB;
constexpr size_t WS_END = 512 * MiB;
constexpr int CW_TMO = 0, CW_BAR = 4096, CW_RS = 131072;

constexpr int RING_BYTES = 131072, MISC_OFF = RING_BYTES + 320, LDS_BYTES = 147456;

#define LDS_WAIT() asm volatile("s_waitcnt lgkmcnt(0)" ::: "memory")
#define VM_WAIT() asm volatile("s_waitcnt vmcnt(0)" ::: "memory")
#define RLX_AGENT __ATOMIC_RELAXED, __HIP_MEMORY_SCOPE_AGENT

__device__ __forceinline__ int opaque_tid() { int t; asm volatile("v_mov_b32_e32 %0, %1" : "=v"(t) : "v"(threadIdx.x)); return t; }
__device__ __forceinline__ unsigned pk_h2(float lo, float hi) { f32x2 v = {lo, hi}; f16x2 h = __builtin_convertvector(v, f16x2); return __builtin_bit_cast(unsigned, h); }
__device__ __forceinline__ float wave_sum(float v) {
#pragma unroll
    for (int o = 1; o < 64; o <<= 1) v += __shfl_xor(v, o);
    return v;
}

#define XB_TMO      128
#define XB_XCNT(j)  (256  + 64 * (j))
#define XB_XSUB(j)  (1280 + 64 * (j))
#define XB_XGEN(j)  (2304 + 64 * (j))
#define XB_TOP      3328
#define XB_TOPGEN   3392
#define XCD_BAR_WORDS 3456
#define XB_SPIN_CAP (1u << 18)
__device__ __forceinline__ unsigned xb_ld(unsigned* p)              { return __hip_atomic_load(p, __ATOMIC_RELAXED, __HIP_MEMORY_SCOPE_AGENT); }
__device__ __forceinline__ unsigned xb_add(unsigned* p, unsigned v) { return __hip_atomic_fetch_add(p, v, __ATOMIC_RELAXED, __HIP_MEMORY_SCOPE_AGENT); }
__device__ __forceinline__ unsigned xb_xcc_id() { return (unsigned)__builtin_amdgcn_s_getreg((3 << 11) | 20) & 0xFu; }
#define XB_SPIN(cond, bar) do { unsigned _sp = 0; while (cond) { __builtin_amdgcn_s_sleep(1); \
    if ((++_sp & 255u) == 0u) { if (xb_ld(&(bar)[XB_TMO])) break; if (_sp > XB_SPIN_CAP) { atomicAdd(&(bar)[XB_TMO], 1u); break; } } } } while (0)
struct XcdBarrier { unsigned* bar; unsigned x; volatile LAS unsigned* st; };
__device__ __forceinline__ XcdBarrier xcd_barrier_post(unsigned* bar, volatile LAS unsigned* st) {
    XcdBarrier b; b.bar = bar; b.x = xb_xcc_id(); b.st = st;
    if (threadIdx.x == 0) (void)xb_add(&bar[XB_XCNT(b.x)], 1u);
    return b;
}
__device__ __forceinline__ void xcd_barrier_complete(unsigned* bar, unsigned x, unsigned& nloc, unsigned& nx) {
    const unsigned G = gridDim.x * gridDim.y * gridDim.z;
    unsigned sum, cnt, mine, sp = 0u;
    for (;;) {
        sum = 0u; cnt = 0u; mine = 0u;
#pragma unroll
        for (unsigned j = 0; j < 16; ++j) { const unsigned c = xb_ld(&bar[XB_XCNT(j)]); sum += c; cnt += (c > 0u) ? 1u : 0u; mine = (j == x) ? c : mine; }
        if (sum == G) break;
        __builtin_amdgcn_s_sleep(1);
        if ((++sp & 255u) == 0u) { if (xb_ld(&bar[XB_TMO])) break; if (sp > XB_SPIN_CAP) { atomicAdd(&bar[XB_TMO], 1u); break; } }
    }
    nloc = mine > 0u ? mine : 1u; nx = cnt > 0u ? cnt : 1u;
}
__device__ __forceinline__ void xcd_barrier(const XcdBarrier& b) {
    asm volatile("s_waitcnt vmcnt(0)" ::: "memory");
    __syncthreads();
    if (threadIdx.x == 0) {
        unsigned* bar = b.bar;
        __builtin_amdgcn_s_waitcnt(0);
        unsigned nloc = b.st[0], nx = b.st[1];
        if (nloc == 0u) { xcd_barrier_complete(bar, b.x, nloc, nx); b.st[0] = nloc; b.st[1] = nx; }
        const unsigned old = xb_add(&bar[XB_XSUB(b.x)], 1u);
        const unsigned gen = old / nloc;
        if (old + 1u == (gen + 1u) * nloc) {
            __builtin_amdgcn_fence(__ATOMIC_RELEASE, "agent");
            asm volatile("s_waitcnt vmcnt(0)" ::: "memory");
            const unsigned og = xb_add(&bar[XB_TOP], 1u);
            const unsigned tg = og / nx;
            if (og + 1u == (tg + 1u) * nx) xb_add(&bar[XB_TOPGEN], 1u);
            else XB_SPIN(xb_ld(&bar[XB_TOPGEN]) == tg, bar);
            __builtin_amdgcn_fence(__ATOMIC_ACQUIRE, "agent");
            xb_add(&bar[XB_XGEN(b.x)], 1u);
            asm volatile("s_waitcnt vmcnt(0)" ::: "memory");
        } else {
            XB_SPIN(xb_ld(&bar[XB_XGEN(b.x)]) == gen, bar);
            __builtin_amdgcn_fence(__ATOMIC_ACQUIRE, "agent");
            asm volatile("s_waitcnt vmcnt(0)" ::: "memory");
        }
    }
    __syncthreads();
}

namespace pg8 {
constexpr int BM = 256, BK = 64, HALF = 128, HTB = HALF * BK * 2;
__host__ __device__ __forceinline__ int lds_byte(int r, int c) { const int st = (r >> 4) * 2 + (c >> 5), rr = r & 15, cc = c & 31, ob = rr * 64 + cc * 2; return st * 1024 + (ob ^ (((ob >> 9) & 1) << 5)); }
__host__ __device__ __forceinline__ void stage_rc(int b, int& R, int& C) { const int st = b / 1024, sb = b % 1024, swz = sb ^ (((sb >> 9) & 1) << 5); R = (st >> 1) * 16 + swz / 64; C = (st & 1) * 32 + (swz % 64) / 2; }
__host__ __device__ __forceinline__ int perm32(int rho) { const int n = rho >> 4, i = rho & 15; return 8 * (i >> 2) + 4 * n + (i & 3); }

struct Unit { int pm, pn, z; const char* A; const char* B; };
struct Gemm { int lda, ldb, K; };

template <class Epi, class Sched, bool ALIGN_EPI>
__device__ __forceinline__ void gemm_phase(LAS unsigned char* lds, const Gemm g, const Sched& S, const Epi& E) {
    const int tid = opaque_tid(), wid = __builtin_amdgcn_readfirstlane(tid >> 6), lane = tid & 63, wr = wid >> 2, wc = wid & 3, fr = lane & 15, fq = lane >> 4;
    const int K = g.K, nt = K / BK;
    unsigned voffA[2], voffB[2];
#pragma unroll
    for (int i = 0; i < 2; ++i) { int R, C; stage_rc(tid * 16 + i * 8192, R, C); const int Rb = Epi::PERM ? ((R & ~31) + perm32(R & 31)) : R;
        voffA[i] = (unsigned)(R * g.lda + C) * 2u; voffB[i] = (unsigned)(Rb * g.ldb + C) * 2u; }
    const size_t kstep = (size_t)(BK * 2);
    const size_t hstepA = (size_t)HALF * g.lda * 2, hstepB = (size_t)HALF * g.ldb * 2;
    const unsigned ldsw = (unsigned)wid * 1024u;
    const int aoff = lds_byte(wr * 64 + fr, fq * 8), boff = lds_byte(wc * 32 + fr, fq * 8);
#define PG8_SA(b, h) (((b) * 2 + (h)) * HTB)
#define PG8_SB(b, h) ((4 + (b) * 2 + (h)) * HTB)
#define PG8_STAGE(bufoff, gbase, voff) do { _Pragma("unroll") for (int _i = 0; _i < 2; ++_i) \
        __builtin_amdgcn_global_load_lds((const unsigned*)((const char*)(gbase) + (voff)[_i]), (LAS unsigned*)(lds + (bufoff) + ldsw + _i * 8192), 16, 0, 0); } while (0)
#define PG8_LDA(dst, b, h) do { _Pragma("unroll") for (int m = 0; m < 4; ++m) _Pragma("unroll") for (int k = 0; k < 2; ++k) dst[m][k] = *(const LAS f16x8*)(lds + PG8_SA(b, h) + aoff + m * 2048 + k * 1024); } while (0)
#define PG8_LDB(dst, b, h) do { _Pragma("unroll") for (int n = 0; n < 2; ++n) _Pragma("unroll") for (int k = 0; k < 2; ++k) dst[n][k] = *(const LAS f16x8*)(lds + PG8_SB(b, h) + boff + n * 2048 + k * 1024); } while (0)
#define PG8_MMA(ai, bj, At, Bt) do { __builtin_amdgcn_s_setprio(1); _Pragma("unroll") for (int m = 0; m < 4; ++m) _Pragma("unroll") for (int n = 0; n < 2; ++n) _Pragma("unroll") for (int k = 0; k < 2; ++k) \
        acc[ai][bj][m][n] = __builtin_amdgcn_mfma_f32_16x16x32_f16(Bt[n][k], At[m][k], acc[ai][bj][m][n], 0, 0, 0); __builtin_amdgcn_s_setprio(0); } while (0)
#define PG8_WAIT_V(n) asm volatile("s_waitcnt vmcnt(" #n ")" ::: "memory")
#define PG8_WAIT_L(n) asm volatile("s_waitcnt lgkmcnt(" #n ")" ::: "memory")
#define PG8_BAR __builtin_amdgcn_s_barrier()
#define PG8_SCHED __builtin_amdgcn_sched_barrier(0)
    Unit cur, nxt; int ui = 0;
    if (!S.next(0, cur)) return;
    f32x4 acc[2][2][4][2];
#pragma unroll
    for (int a = 0; a < 2; ++a)
#pragma unroll
        for (int b = 0; b < 2; ++b)
#pragma unroll
            for (int m = 0; m < 4; ++m)
#pragma unroll
                for (int n = 0; n < 2; ++n) acc[a][b][m][n] = (f32x4){0.f, 0.f, 0.f, 0.f};
    f16x8 At[4][2], B0[2][2], B1[2][2];
    const char* cA = cur.A; const char* cB = cur.B;
    PG8_STAGE(PG8_SB(0, 0), cB, voffB); PG8_STAGE(PG8_SB(0, 1), cB + hstepB, voffB); PG8_STAGE(PG8_SA(0, 0), cA, voffA); PG8_STAGE(PG8_SA(0, 1), cA + hstepA, voffA);
    if (wr == 1) PG8_BAR;
    PG8_WAIT_V(2); PG8_BAR;
    PG8_STAGE(PG8_SB(1, 0), cB + kstep, voffB); PG8_STAGE(PG8_SA(1, 0), cA + kstep, voffA); PG8_STAGE(PG8_SB(1, 1), cB + hstepB + kstep, voffB);
    PG8_WAIT_V(6); PG8_BAR;
    for (;;) {
        const bool has_next = S.next(ui + 1, nxt);
        const char* nA = has_next ? nxt.A : cA; const char* nB = has_next ? nxt.B : cB;
#pragma clang loop unroll(disable)
        for (int t = 0; t < nt; t += 2) {
            const bool last = (t == nt - 2);
            const char* a1 = cA + (size_t)(t + 1) * kstep;
            const char* a2 = last ? nA : cA + (size_t)(t + 2) * kstep; const char* b2 = last ? nB : cB + (size_t)(t + 2) * kstep;
            const char* a3 = a2 + kstep; const char* b3 = b2 + kstep;
            PG8_LDB(B0, 0, 0); PG8_LDB(B1, 0, 1); PG8_SCHED; PG8_LDA(At, 0, 0); PG8_STAGE(PG8_SA(1, 1), a1 + hstepA, voffA);
            PG8_WAIT_V(8); PG8_WAIT_L(0); PG8_BAR; PG8_MMA(0, 0, At, B0); PG8_MMA(0, 1, At, B1); PG8_BAR; PG8_SCHED;
            PG8_LDA(At, 0, 1); PG8_STAGE(PG8_SB(0, 0), b2, voffB); PG8_STAGE(PG8_SB(0, 1), b2 + hstepB, voffB); PG8_STAGE(PG8_SA(0, 0), a2, voffA);
            PG8_WAIT_V(8); PG8_WAIT_L(0); PG8_BAR; PG8_MMA(1, 0, At, B0); PG8_MMA(1, 1, At, B1); PG8_BAR; PG8_SCHED;
            PG8_LDB(B0, 1, 0); PG8_LDB(B1, 1, 1); PG8_SCHED; PG8_LDA(At, 1, 0); PG8_STAGE(PG8_SA(0, 1), a2 + hstepA, voffA);
            PG8_WAIT_V(8); PG8_WAIT_L(0); PG8_BAR; PG8_MMA(0, 0, At, B0); PG8_MMA(0, 1, At, B1); PG8_BAR; PG8_SCHED;
            PG8_LDA(At, 1, 1); PG8_STAGE(PG8_SB(1, 0), b3, voffB); PG8_STAGE(PG8_SB(1, 1), b3 + hstepB, voffB); PG8_STAGE(PG8_SA(1, 0), a3, voffA);
            PG8_WAIT_V(8); PG8_WAIT_L(0); PG8_BAR; PG8_MMA(1, 0, At, B0); PG8_MMA(1, 1, At, B1); PG8_BAR; PG8_SCHED;
        }
        if constexpr (ALIGN_EPI) { if (wr == 0) PG8_BAR; }
        if constexpr (!Epi::AFTER_DRAIN) { E(acc, cur, wr, wc, fr, fq); }
        if (!has_next) break;
#pragma unroll
        for (int a = 0; a < 2; ++a)
#pragma unroll
            for (int b = 0; b < 2; ++b)
#pragma unroll
                for (int m = 0; m < 4; ++m)
#pragma unroll
                    for (int n = 0; n < 2; ++n) acc[a][b][m][n] = (f32x4){0.f, 0.f, 0.f, 0.f};
        cur = nxt; cA = nA; cB = nB; ++ui;
        if constexpr (ALIGN_EPI) { if (wr == 1) PG8_BAR; }
    }
    PG8_WAIT_V(0);
    if constexpr (!ALIGN_EPI) { if (wr == 0) PG8_BAR; }
    PG8_BAR;
    if constexpr (Epi::AFTER_DRAIN) { E.fused(acc, cur, wr, wc, fr, fq, lds, wid, lane); }
#undef PG8_SA
#undef PG8_SB
#undef PG8_STAGE
#undef PG8_LDA
#undef PG8_LDB
#undef PG8_MMA
#undef PG8_WAIT_V
#undef PG8_WAIT_L
#undef PG8_BAR
#undef PG8_SCHED
}
}
using pg8::Unit;

struct Args {
    const float* x; const float* mem; const int* pos; const float* w_in; const float* q_norm_g; const float* w_uq; const float* kv_norm_g; const float* w_uk; const float* w_uv;
    const float* conv_w; const float* conv_b; const float* conv_ln_g; const float* conv_ln_b; const float* w_o; const float* ln1_g; const float* ln1_b;
    const float* xa_w_q; const float* xa_w_k; const float* xa_w_v; const float* xa_w_o; const float* ln2_g; const float* ln2_b;
    const float* w_router; const float* w_gate; const float* w_up; const float* w_down; const float* ln3_g; const float* ln3_b;
    float* out; unsigned char* ws;
    float invf[16];
    int ph_lo, ph_hi;
};

struct Frame { LAS unsigned char* lds; int tid, lane, wave, vcu, G; unsigned char* ws; };
__device__ __forceinline__ void frame_ids(Frame& F) { const int t = opaque_tid(); F.tid = t; F.lane = t & 63; F.wave = __builtin_amdgcn_readfirstlane(t >> 6); }

template <int MODE>
__device__ __forceinline__ void tr_item(const float* W, int K, int N, f16* WT, int ldt, int row_off, int col_off, const float* kscale, LAS float* scr, int item, int lane) {
    const int nblk = N / 32, kb = item / nblk, nb = item % nblk, k0 = 64 * kb, n0 = 32 * nb;
    const float* wp = W + (size_t)(k0 + (lane >> 5)) * N + n0 + (lane & 31);
    float v[32];
#pragma unroll
    for (int i = 0; i < 32; ++i) v[i] = wp[(size_t)(2 * i) * N];
    if (kscale) {
#pragma unroll
        for (int i = 0; i < 32; ++i) v[i] *= kscale[k0 + 2 * i + (lane >> 5)]; }
#pragma unroll
    for (int i = 0; i < 32; ++i) scr[(2 * i + (lane >> 5)) * 33 + (lane & 31)] = v[i];
    LDS_WAIT(); asm volatile("" ::: "memory");
    const int c = lane & 7;
#pragma unroll
    for (int j = 0; j < 4; ++j) { const int n = (lane >> 3) + 8 * j; const LAS float* s = scr + (8 * c) * 33 + n;
        u32x4 o; o.x = pk_h2(s[0 * 33], s[1 * 33]); o.y = pk_h2(s[2 * 33], s[3 * 33]); o.z = pk_h2(s[4 * 33], s[5 * 33]); o.w = pk_h2(s[6 * 33], s[7 * 33]);
        const int nn = n0 + n; const int drow = (MODE == 0) ? (row_off + nn) : (row_off + 256 * (nn >> 7) + (nn & 127));
        *(GAS u32x4*)(WT + (size_t)drow * ldt + col_off + k0 + 8 * c) = o; }
    LDS_WAIT(); asm volatile("" ::: "memory");
}
struct TrD { const float* wp; f16* dst; int N, ldt; };
__device__ __forceinline__ void moe_decode(const float* w_gate, const float* w_up, const float* w_down, f16* WGU, f16* WD, int r, int lane, TrD& d) {
    const int e = r / 3072, q = r % 3072; const float* W; f16* WT; int N, item, roff;
    if (q < 2048) { const int up = q >> 10; item = q & 1023; W = (up ? w_up : w_gate) + (size_t)e * 1024 * 2048; N = 2048; d.ldt = 1024;
        const int kb = item >> 6, nb = item & 63, n0 = 32 * nb; roff = 128 * up + 256 * (n0 >> 7) + (n0 & 127);
        WT = WGU + (size_t)e * 4096 * 1024 + (size_t)roff * 1024 + 64 * kb; d.wp = W + (size_t)(64 * kb + (lane >> 5)) * N + n0 + (lane & 31); }
    else { item = q - 2048; W = w_down + (size_t)e * 2048 * 1024; N = 1024; d.ldt = 2048;
        const int kb = item >> 5, nb = item & 31, n0 = 32 * nb;
        WT = WD + (size_t)e * 1024 * 2048 + (size_t)n0 * 2048 + 64 * kb; d.wp = W + (size_t)(64 * kb + (lane >> 5)) * N + n0 + (lane & 31); }
    d.dst = WT; d.N = N;
}
__device__ __forceinline__ void tr_load(const TrD& d, float (&v)[32]) {
#pragma unroll
    for (int i = 0; i < 32; ++i) v[i] = d.wp[(size_t)(2 * i) * d.N];
}
__device__ __forceinline__ void tr_finish(const TrD& d, const float (&v)[32], LAS float* scr, int lane) {
#pragma unroll
    for (int i = 0; i < 32; ++i) scr[(2 * i + (lane >> 5)) * 33 + (lane & 31)] = v[i];
    LDS_WAIT(); asm volatile("" ::: "memory");
    const int c = lane & 7;
#pragma unroll
    for (int j = 0; j < 4; ++j) { const int n = (lane >> 3) + 8 * j; const LAS float* s = scr + (8 * c) * 33 + n;
        u32x4 o; o.x = pk_h2(s[0 * 33], s[1 * 33]); o.y = pk_h2(s[2 * 33], s[3 * 33]); o.z = pk_h2(s[4 * 33], s[5 * 33]); o.w = pk_h2(s[6 * 33], s[7 * 33]);
        *(GAS u32x4*)(d.dst + (size_t)n * d.ldt + 8 * c) = o; }
    LDS_WAIT(); asm volatile("" ::: "memory");
}
__device__ __forceinline__ void cvt_rows(const float* src, f16* dst, size_t n8, int gw, int NGW, int lane) {
    for (size_t i0 = (size_t)gw * 256 + lane; i0 < n8; i0 += (size_t)NGW * 256) {
        f32x4 a[4], b[4];
#pragma unroll
        for (int q = 0; q < 4; ++q) { a[q] = *(const GAS f32x4*)(src + (i0 + 64 * q) * 8); b[q] = *(const GAS f32x4*)(src + (i0 + 64 * q) * 8 + 4); }
#pragma unroll
        for (int q = 0; q < 4; ++q) { u32x4 o; o.x = pk_h2(a[q].x, a[q].y); o.y = pk_h2(a[q].z, a[q].w); o.z = pk_h2(b[q].x, b[q].y); o.w = pk_h2(b[q].z, b[q].w);
            *(GAS u32x4*)(dst + (i0 + 64 * q) * 8) = o; } }
}
__device__ __forceinline__ void zero_block(f16* base, int ld, int nrows, int ncols8, int gw, int NGW, int lane) {
    const u32x4 z = {0u, 0u, 0u, 0u};
    for (size_t i = (size_t)gw * 64 + lane; i < (size_t)nrows * ncols8; i += (size_t)NGW * 64) { const size_t r = i / ncols8, c = i % ncols8; *(GAS u32x4*)(base + r * ld + c * 8) = z; }
}
typedef const __attribute__((address_space(4))) Args* KArgs;
__device__ __forceinline__ void p0_prologue(KArgs ap, Frame& F) { const auto& a = *ap;
    LAS float* scr = (LAS float*)(F.lds + F.wave * 16384);
    const int gw = F.vcu * NWAVES + F.wave, NGW = F.G * NWAVES, lane = F.lane;
    unsigned char* ws = F.ws;
    f16* WIN = (f16*)(ws + WS_WIN); f16* WUP = (f16*)(ws + WS_WUP); f16* WGU = (f16*)(ws + WS_WGU); f16* WD = (f16*)(ws + WS_WD);
    constexpr int I_IN = 16 * 45, I_UQ = 4 * 24, I_UK = 2 * 16, I_SQ = 16 * 32, I_G = 16 * 64, I_DN = 32 * 32;
    constexpr int NSMALL = I_IN + I_UQ + 2 * I_UK + 5 * I_SQ;
    for (int it = gw; it < NSMALL; it += NGW) {
        int r = it;
        if (r < I_IN) { tr_item<0>(a.w_in, 1024, 1440, WIN, 1024, 0, 0, nullptr, scr, r, lane); continue; } r -= I_IN;
        if (r < I_UQ) { tr_item<0>(a.w_uq, 256, 768, WUP, 384, 0, 0, a.q_norm_g, scr, r, lane); continue; } r -= I_UQ;
        if (r < I_UK) { tr_item<0>(a.w_uk, 128, 512, WUP, 384, 768, 256, a.kv_norm_g, scr, r, lane); continue; } r -= I_UK;
        if (r < I_UK) { tr_item<0>(a.w_uv, 128, 512, WUP, 384, 1280, 256, a.kv_norm_g, scr, r, lane); continue; } r -= I_UK;
        if (r < I_SQ) { tr_item<0>(a.w_o, 1024, 1024, (f16*)(ws + WS_WO), 1024, 0, 0, nullptr, scr, r, lane); continue; } r -= I_SQ;
        if (r < I_SQ) { tr_item<0>(a.xa_w_q, 1024, 1024, (f16*)(ws + WS_XWQ), 1024, 0, 0, nullptr, scr, r, lane); continue; } r -= I_SQ;
        if (r < I_SQ) { tr_item<0>(a.xa_w_k, 1024, 1024, (f16*)(ws + WS_XWK), 1024, 0, 0, nullptr, scr, r, lane); continue; } r -= I_SQ;
        if (r < I_SQ) { tr_item<0>(a.xa_w_v, 1024, 1024, (f16*)(ws + WS_XWV), 1024, 0, 0, nullptr, scr, r, lane); continue; } r -= I_SQ;
        tr_item<0>(a.xa_w_o, 1024, 1024, (f16*)(ws + WS_XWO), 1024, 0, 0, nullptr, scr, r, lane);
    }
    {
        constexpr int NMOE = NE * 3072; static_assert(2 * I_G + I_DN == 3072, "items per expert");
        const float* wg = a.w_gate; const float* wu = a.w_up; const float* wd = a.w_down;
        float va[32], vb[32]; TrD da, db; int r = gw;
        if (r < NMOE) { moe_decode(wg, wu, wd, WGU, WD, r, lane, da); tr_load(da, va); }
        while (r < NMOE) {
            const int r2 = r + NGW; if (r2 < NMOE) { moe_decode(wg, wu, wd, WGU, WD, r2, lane, db); tr_load(db, vb); }
            tr_finish(da, va, scr, lane);
            r = r2; if (r >= NMOE) break;
            const int r3 = r + NGW; if (r3 < NMOE) { moe_decode(wg, wu, wd, WGU, WD, r3, lane, da); tr_load(da, va); }
            tr_finish(db, vb, scr, lane);
            r = r3;
        }
    }
    zero_block(WIN + (size_t)1440 * 1024, 1024, 96, 128, gw, NGW, lane);
    zero_block(WUP + 256, 384, 768, 16, gw, NGW, lane);
    zero_block(WUP + (size_t)768 * 384, 384, 1024, 32, gw, NGW, lane);
    cvt_rows(a.x, (f16*)(ws + WS_XH), (size_t)T * D / 8, gw, NGW, lane);
    cvt_rows(a.mem, (f16*)(ws + WS_MEMH), (size_t)MT * D / 8, gw, NGW, lane);
    float* CS = (float*)(ws + WS_CS);
    for (int i = gw * 64 + lane; i < T * 16; i += NGW * 64) {
        const int t = i >> 4, k = i & 15; const float ang = (float)a.pos[t] * a.invf[k];
        const double rev = (double)ang * 0.15915494309189533577; const float fr = (float)(rev - floor(rev));
        *(GAS f32x2*)(CS + (size_t)i * 2) = (f32x2){__builtin_amdgcn_cosf(fr), __builtin_amdgcn_sinf(fr)}; }
}

struct SchedG1 { int vcu, G; const char* XH; const char* WIN; const char* MEMH; const char* XWK; const char* XWV;
    __device__ __forceinline__ bool next(int i, Unit& u) const { const int L = i * G + vcu; if (L >= 448) return false;
        if (L < 384) { u.z = 0; u.pm = L / 6; u.pn = L % 6; u.A = XH + (size_t)u.pm * 256 * 1024 * 2; u.B = WIN + (size_t)u.pn * 256 * 1024 * 2; }
        else { const int j = L - 384;
            if (j < 32) { u.z = 1; u.pm = j >> 2; u.pn = j & 3; u.A = MEMH + (size_t)u.pm * 256 * 1024 * 2; u.B = XWK + (size_t)u.pn * 256 * 1024 * 2; }
            else { const int q = j - 32; u.z = 2; u.pm = q >> 3; u.pn = q & 7; u.A = XWV + (size_t)u.pm * 256 * 1024 * 2; u.B = MEMH + (size_t)u.pn * 256 * 1024 * 2; } }
        return true; } };
struct SchedGrid { int vcu, G, nN, total; const char* A; const char* B; size_t astep, bstep;
    __device__ __forceinline__ bool next(int i, Unit& u) const { const int L = i * G + vcu; if (L >= total) return false;
        u.z = 0; u.pm = L / nN; u.pn = L % nN; u.A = A + (size_t)u.pm * astep; u.B = B + (size_t)u.pn * bstep; return true; } };
struct SchedXS { int vcu, G; const char* A; const char* B; int mode;
    __device__ __forceinline__ bool next(int i, Unit& u) const { const int L = i * G + vcu; if (L >= 256) return false;
        const int b = L >> 5, h = (L >> 3) & 3, qb = L & 7; u.z = b; u.pm = b * 8 + qb; u.pn = h;
        u.A = A + ((size_t)(b * SEQ + qb * 256) * 1024 + (mode == 2 ? 0 : h * 256)) * 2;
        u.B = (mode == 2) ? B + (size_t)(h * 256) * 1024 * 2 : (mode == 0) ? B + ((size_t)(b * MEML) * 1024 + h * 256) * 2 : B + ((size_t)(h * 256) * MT + b * MEML) * 2;
        return true; } };
struct SchedMoE { int vcu, G, npn, total; const char* A; const char* B; size_t a_e, b_e, astep, bstep;
    __device__ __forceinline__ bool next(int i, Unit& u) const { const int L = i * G + vcu; if (L >= total) return false;
        const int per = 8 * npn, e = L / per, r = L % per; u.z = e; u.pn = r >> 3; u.pm = r & 7;
        u.A = A + (size_t)e * a_e + (size_t)u.pm * astep; u.B = B + (size_t)e * b_e + (size_t)u.pn * bstep; return true; } };

struct EpiG1 {
    static constexpr bool PERM = true, AFTER_DRAIN = false;
    f16* HCAT; f16* MK; f16* MVT; float* RS;
    __device__ __forceinline__ void operator()(const f32x4 (&acc)[2][2][4][2], const Unit& u, int wr, int wc, int fr, int fq) const {
        f16* base; int ld;
        if (u.z == 0) { base = HCAT + (size_t)(u.pm * 256) * LDH + u.pn * 256; ld = LDH; }
        else if (u.z == 1) { base = MK + (size_t)(u.pm * 256) * 1024 + u.pn * 256; ld = 1024; }
        else { base = MVT + (size_t)(u.pm * 256) * MT + u.pn * 256; ld = MT; }
        const int row0 = wr * 64 + fr, col0 = wc * 32 + 8 * fq;
        const bool stat = (u.z == 0 && u.pn < 2);
#pragma unroll
        for (int ai = 0; ai < 2; ++ai)
#pragma unroll
            for (int m = 0; m < 4; ++m) { const int row = row0 + ai * 128 + m * 16; f16* rowp = base + (size_t)row * ld + col0; float ss[2];
#pragma unroll
                for (int bj = 0; bj < 2; ++bj) { const f32x4 v0 = acc[ai][bj][m][0], v1 = acc[ai][bj][m][1];
                    u32x4 w; w.x = pk_h2(v0[0], v0[1]); w.y = pk_h2(v0[2], v0[3]); w.z = pk_h2(v1[0], v1[1]); w.w = pk_h2(v1[2], v1[3]);
                    *(GAS u32x4*)(rowp + bj * 128) = w;
                    ss[bj] = (v0[0] * v0[0] + v0[1] * v0[1]) + (v0[2] * v0[2] + v0[3] * v0[3]) + (v1[0] * v1[0] + v1[1] * v1[1]) + (v1[2] * v1[2] + v1[3] * v1[3]); }
                if (stat) { float s = (u.pn == 0) ? ss[0] + ss[1] : ss[0]; s += __shfl_xor(s, 16); s += __shfl_xor(s, 32);
                    if (fq == 0) atomicAdd(RS + (size_t)(u.pm * 256 + row) * 2 + u.pn, s); } }
    }
};
struct EpiUP {
    static constexpr bool PERM = false, AFTER_DRAIN = false;
    f16* Q; f16* Kb; f16* V; const float* RS; const float* CS;
    __device__ __forceinline__ void operator()(const f32x4 (&acc)[2][2][4][2], const Unit& u, int wr, int wc, int fr, int fq) const {
        const int pn = u.pn, row0 = u.pm * 256 + wr * 64 + fr;
#pragma unroll
        for (int ai = 0; ai < 2; ++ai)
#pragma unroll
            for (int m = 0; m < 4; ++m) { const int row = row0 + ai * 128 + m * 16;
                const f32x2 rs = *(const GAS f32x2*)(RS + (size_t)row * 2);
                if (pn < 3) { const float sc = __builtin_amdgcn_rsqf(rs.x * (1.0f / 256.0f) + EPS) * QSCALE;
#pragma unroll
                    for (int bj = 0; bj < 2; ++bj) { const int g32 = 8 * pn + 4 * bj + wc; f32x4 x0 = acc[ai][bj][m][0] * sc, x1 = acc[ai][bj][m][1] * sc;
                        if (g32 % 3 == 2) { const f32x4 c01 = *(const GAS f32x4*)(CS + (size_t)row * 32 + fq * 8), c23 = *(const GAS f32x4*)(CS + (size_t)row * 32 + fq * 8 + 4);
                            const f32x4 cs = {c01[0], c01[2], c23[0], c23[2]}, sn = {c01[1], c01[3], c23[1], c23[3]};
                            const f32x4 o0 = x0 * cs - x1 * sn, o1 = x1 * cs + x0 * sn; x0 = o0; x1 = o1; }
                        f16* p = Q + (size_t)row * 768 + g32 * 32 + 4 * fq;
                        *(GAS u32x2*)p = (u32x2){pk_h2(x0[0], x0[1]), pk_h2(x0[2], x0[3])}; *(GAS u32x2*)(p + 16) = (u32x2){pk_h2(x1[0], x1[1]), pk_h2(x1[2], x1[3])}; }
                } else { const float sc = __builtin_amdgcn_rsqf(rs.y * (1.0f / 128.0f) + EPS);
#pragma unroll
                    for (int bj = 0; bj < 2; ++bj)
#pragma unroll
                        for (int n = 0; n < 2; ++n) { const f32x4 x = acc[ai][bj][m][n] * sc; const int c = 256 * ((pn - 3) & 1) + 128 * bj + 32 * wc + 16 * n + 4 * fq;
                            f16* p = (pn < 5) ? Kb + (size_t)row * 768 + (c >> 6) * 96 + (c & 63) : V + (size_t)row * 512 + c;
                            *(GAS u32x2*)p = (u32x2){pk_h2(x[0], x[1]), pk_h2(x[2], x[3])}; }
                }
                asm volatile("" ::: "memory"); }
    }
};
struct EpiPre {
    static constexpr bool PERM = false, AFTER_DRAIN = false;
    const f16* R; float* PRE;
    __device__ __forceinline__ void operator()(const f32x4 (&acc)[2][2][4][2], const Unit& u, int wr, int wc, int fr, int fq) const {
        const int row0 = u.pm * 256 + wr * 64 + fr, col0 = u.pn * 256 + wc * 32 + 4 * fq;
#pragma unroll
        for (int ai = 0; ai < 2; ++ai)
#pragma unroll
            for (int m = 0; m < 4; ++m) { const size_t off = (size_t)(row0 + ai * 128 + m * 16) * D + col0;
#pragma unroll
                for (int bj = 0; bj < 2; ++bj)
#pragma unroll
                    for (int n = 0; n < 2; ++n) { const f16x4 r = *(const GAS f16x4*)(R + off + bj * 128 + n * 16);
                        *(GAS f32x4*)(PRE + off + bj * 128 + n * 16) = acc[ai][bj][m][n] + (f32x4){(float)r[0], (float)r[1], (float)r[2], (float)r[3]} * ALPHA; } }
    }
};
struct EpiH16 {
    static constexpr bool PERM = true, AFTER_DRAIN = false;
    f16* O; int ld; float scale;
    __device__ __forceinline__ void operator()(const f32x4 (&acc)[2][2][4][2], const Unit& u, int wr, int wc, int fr, int fq) const {
        f16* base = O + (size_t)(u.pm * 256 + wr * 64 + fr) * ld + u.pn * 256 + wc * 32 + 8 * fq;
#pragma unroll
        for (int ai = 0; ai < 2; ++ai)
#pragma unroll
            for (int m = 0; m < 4; ++m) { f16* rowp = base + (size_t)(ai * 128 + m * 16) * ld;
#pragma unroll
                for (int bj = 0; bj < 2; ++bj) { const f32x4 v0 = acc[ai][bj][m][0] * scale, v1 = acc[ai][bj][m][1] * scale;
                    u32x4 w; w.x = pk_h2(v0[0], v0[1]); w.y = pk_h2(v0[2], v0[3]); w.z = pk_h2(v1[0], v1[1]); w.w = pk_h2(v1[2], v1[3]);
                    *(GAS u32x4*)(rowp + bj * 128) = w; } }
    }
};
struct EpiSoftmax {
    static constexpr bool PERM = true, AFTER_DRAIN = true;
    f16* P;
    __device__ __forceinline__ void fused(f32x4 (&acc)[2][2][4][2], const Unit& u, int wr, int wc, int fr, int fq, LAS unsigned char* lds, int wid, int lane) const {
        LAS float* RM = (LAS float*)lds; LAS float* RSM = (LAS float*)(lds + 4096);
#pragma unroll
        for (int ai = 0; ai < 2; ++ai)
#pragma unroll
            for (int m = 0; m < 4; ++m) { float v = -3.0e38f;
#pragma unroll
                for (int bj = 0; bj < 2; ++bj)
#pragma unroll
                    for (int n = 0; n < 2; ++n) { const f32x4 x = acc[ai][bj][m][n]; v = fmaxf(v, fmaxf(fmaxf(x[0], x[1]), fmaxf(x[2], x[3]))); }
                v = fmaxf(v, __shfl_xor(v, 16)); v = fmaxf(v, __shfl_xor(v, 32));
                if (fq == 0) RM[(ai * 128 + wr * 64 + m * 16 + fr) * 4 + wc] = v; }
        asm volatile("s_waitcnt lgkmcnt(0)" ::: "memory"); __builtin_amdgcn_s_barrier(); asm volatile("" ::: "memory");
#pragma unroll
        for (int ai = 0; ai < 2; ++ai)
#pragma unroll
            for (int m = 0; m < 4; ++m) { const f32x4 r = *(const LAS f32x4*)(RM + (ai * 128 + wr * 64 + m * 16 + fr) * 4); const float mx = fmaxf(fmaxf(r[0], r[1]), fmaxf(r[2], r[3])); float s = 0.f;
#pragma unroll
                for (int bj = 0; bj < 2; ++bj)
#pragma unroll
                    for (int n = 0; n < 2; ++n) { f32x4 x = acc[ai][bj][m][n];
#pragma unroll
                        for (int j = 0; j < 4; ++j) { x[j] = __builtin_amdgcn_exp2f(x[j] - mx); s += x[j]; }
                        acc[ai][bj][m][n] = x; }
                s += __shfl_xor(s, 16); s += __shfl_xor(s, 32);
                if (fq == 0) RSM[(ai * 128 + wr * 64 + m * 16 + fr) * 4 + wc] = s;
                asm volatile("" ::: "memory"); }
        asm volatile("s_waitcnt lgkmcnt(0)" ::: "memory"); __builtin_amdgcn_s_barrier(); asm volatile("" ::: "memory");
        f16* base = P + (size_t)(u.pm * 256 + wr * 64 + fr) * 1024 + u.pn * 256 + wc * 32 + 8 * fq;
#pragma unroll
        for (int ai = 0; ai < 2; ++ai)
#pragma unroll
            for (int m = 0; m < 4; ++m) { const f32x4 r = *(const LAS f32x4*)(RSM + (ai * 128 + wr * 64 + m * 16 + fr) * 4); const float inv = 1.0f / ((r[0] + r[1]) + (r[2] + r[3]));
                f16* rowp = base + (size_t)(ai * 128 + m * 16) * 1024;
#pragma unroll
                for (int bj = 0; bj < 2; ++bj) { const f32x4 v0 = acc[ai][bj][m][0] * inv, v1 = acc[ai][bj][m][1] * inv;
                    u32x4 w; w.x = pk_h2(v0[0], v0[1]); w.y = pk_h2(v0[2], v0[3]); w.z = pk_h2(v1[0], v1[1]); w.w = pk_h2(v1[2], v1[3]);
                    *(GAS u32x4*)(rowp + bj * 128) = w; }
                asm volatile("" ::: "memory"); }
    }
};
struct EpiHid {
    static constexpr bool PERM = true, AFTER_DRAIN = false;
    f16* HID;
    __device__ __forceinline__ void operator()(const f32x4 (&acc)[2][2][4][2], const Unit& u, int wr, int wc, int fr, int fq) const {
        f16* base = HID + (size_t)(u.z * 2048 + u.pm * 256 + wr * 64 + fr) * FF + u.pn * 128 + wc * 32 + 8 * fq;
#pragma unroll
        for (int ai = 0; ai < 2; ++ai)
#pragma unroll
            for (int m = 0; m < 4; ++m) { f32x4 h[2];
#pragma unroll
                for (int n = 0; n < 2; ++n) { const f32x4 g = acc[ai][0][m][n], up = acc[ai][1][m][n];
#pragma unroll
                    for (int j = 0; j < 4; ++j) h[n][j] = g[j] * __builtin_amdgcn_rcpf(1.0f + __builtin_amdgcn_exp2f(-g[j] * LOG2E)) * up[j]; }
                u32x4 w; w.x = pk_h2(h[0][0], h[0][1]); w.y = pk_h2(h[0][2], h[0][3]); w.z = pk_h2(h[1][0], h[1][1]); w.w = pk_h2(h[1][2], h[1][3]);
                *(GAS u32x4*)(base + (size_t)(ai * 128 + m * 16) * FF) = w; }
    }
};
struct EpiY {
    static constexpr bool PERM = true, AFTER_DRAIN = false;
    f16* Y; const float* GATE;
    __device__ __forceinline__ void operator()(const f32x4 (&acc)[2][2][4][2], const Unit& u, int wr, int wc, int fr, int fq) const {
        const int r0 = wr * 64 + fr; const float* gp = GATE + (size_t)(u.pm * NE + u.z) * CAP;
        f16* base = Y + (size_t)(u.z * 2048 + u.pm * 256 + r0) * D + u.pn * 256 + wc * 32 + 8 * fq;
#pragma unroll
        for (int ai = 0; ai < 2; ++ai)
#pragma unroll
            for (int m = 0; m < 4; ++m) { const float gt = gp[r0 + ai * 128 + m * 16]; f16* rowp = base + (size_t)(ai * 128 + m * 16) * D;
#pragma unroll
                for (int bj = 0; bj < 2; ++bj) { const f32x4 v0 = acc[ai][bj][m][0] * gt, v1 = acc[ai][bj][m][1] * gt;
                    u32x4 w; w.x = pk_h2(v0[0], v0[1]); w.y = pk_h2(v0[2], v0[3]); w.z = pk_h2(v1[0], v1[1]); w.w = pk_h2(v1[2], v1[3]);
                    *(GAS u32x4*)(rowp + bj * 128) = w; } }
    }
};

__device__ __forceinline__ void krope_pass(Frame& F) {
    const f16* HC = (const f16*)(F.ws + WS_HCAT); f16* Kb = (f16*)(F.ws + WS_K); const float* CS = (const float*)(F.ws + WS_CS);
    for (int i = (F.vcu * NTHR + F.tid); i < T * 16; i += F.G * NTHR) { const int t = i >> 4, k = i & 15;
        const float x1 = (float)HC[(size_t)t * LDH + 384 + k], x2 = (float)HC[(size_t)t * LDH + 400 + k]; const f32x2 cs = *(const GAS f32x2*)(CS + (size_t)i * 2);
        const f16 o1 = (f16)(x1 * cs.x - x2 * cs.y), o2 = (f16)(x2 * cs.x + x1 * cs.y);
#pragma unroll
        for (int h = 0; h < 8; ++h) { Kb[(size_t)t * 768 + h * 96 + 64 + k] = o1; Kb[(size_t)t * 768 + h * 96 + 80 + k] = o2; } }
}
__device__ __forceinline__ void conv_phase(KArgs ap, Frame& F) { const auto& a = *ap;
    LAS f16* GL = (LAS f16*)F.lds;
    LAS float* RED = (LAS float*)(F.lds + 62 * 512 * 2);
    LAS float* STAT = RED + 8 * 32 * 2;
    const f16* HC = (const f16*)(F.ws + WS_HCAT); f16* AO = (f16*)(F.ws + WS_AO);
    const int tid = F.tid, lane = F.lane, wave = F.wave;
    f16x2 W[16];
#pragma unroll
    for (int i = 0; i < 15; ++i) W[i] = (f16x2){(f16)a.conv_w[(2 * i) * CCH + tid], (f16)a.conv_w[(2 * i + 1) * CCH + tid]};
    W[15] = (f16x2){(f16)a.conv_w[30 * CCH + tid], (f16)0.f};
    const float cb = a.conv_b[tid], lg = a.conv_ln_g[tid], lb = a.conv_ln_b[tid];
    for (int tile = F.vcu; tile < T / 32; tile += F.G) {
        const int t0 = tile * 32, s0 = t0 % SEQ;
        for (int i = tid; i < 62 * 64; i += NTHR) { const int r = i >> 6, c8 = (i & 63) * 8; const int s = s0 - CPAD + r;
            u32x4 o = {0u, 0u, 0u, 0u};
            if (s >= 0 && s < SEQ) { const f16* hp = HC + (size_t)(t0 - CPAD + r) * LDH + 416 + c8;
                const f16x8 av = *(const GAS f16x8*)hp, gv = *(const GAS f16x8*)(hp + 512); float y[8];
#pragma unroll
                for (int j = 0; j < 8; ++j) { const float g = (float)gv[j]; y[j] = (float)av[j] * __builtin_amdgcn_rcpf(1.0f + __builtin_amdgcn_exp2f(-g * LOG2E)); }
                o.x = pk_h2(y[0], y[1]); o.y = pk_h2(y[2], y[3]); o.z = pk_h2(y[4], y[5]); o.w = pk_h2(y[6], y[7]); }
            *(LAS u32x4*)(GL + r * 512 + c8) = o; }
        __syncthreads();
        f16x2 E[31], O[31];
        { f16 g[63];
#pragma unroll
          for (int r = 0; r < 62; ++r) g[r] = GL[r * 512 + tid];
          g[62] = (f16)0.f;
#pragma unroll
          for (int i = 0; i < 31; ++i) { E[i] = (f16x2){g[2 * i], g[2 * i + 1]}; O[i] = (f16x2){g[2 * i + 1], g[2 * i + 2]}; } }
        float out[32];
#pragma unroll
        for (int s = 0; s < 32; ++s) { float acc = cb; const int m = s >> 1;
#pragma unroll
            for (int i = 0; i < 16; ++i) acc = __builtin_amdgcn_fdot2((s & 1) ? O[m + i] : E[m + i], W[i], acc, false);
            out[s] = acc; }
        float s1[32], s2[32];
#pragma unroll
        for (int s = 0; s < 32; ++s) { s1[s] = out[s]; s2[s] = out[s] * out[s]; }
#define RSTEP(A, N, BIT) _Pragma("unroll") for (int k = 0; k < N; ++k) { const bool up = (lane >> BIT) & 1; const float send = up ? A[k] : A[k + N], keep = up ? A[k + N] : A[k]; A[k] = keep + __shfl_xor(send, 1 << BIT); }
        RSTEP(s1, 16, 4) RSTEP(s1, 8, 3) RSTEP(s1, 4, 2) RSTEP(s1, 2, 1) RSTEP(s1, 1, 0)
        RSTEP(s2, 16, 4) RSTEP(s2, 8, 3) RSTEP(s2, 4, 2) RSTEP(s2, 2, 1) RSTEP(s2, 1, 0)
#undef RSTEP
        const float t1 = s1[0] + __shfl_xor(s1[0], 32), t2 = s2[0] + __shfl_xor(s2[0], 32);
        if (lane < 32) *(LAS f32x2*)(RED + (wave * 32 + lane) * 2) = (f32x2){t1, t2};
        __syncthreads();
        if (tid < 32) { float a1 = 0.f, a2 = 0.f;
#pragma unroll
            for (int w = 0; w < 8; ++w) { const f32x2 p = *(const LAS f32x2*)(RED + (w * 32 + tid) * 2); a1 += p.x; a2 += p.y; }
            const float mean = a1 * (1.0f / CCH), var = fmaxf(a2 * (1.0f / CCH) - mean * mean, 0.f);
            *(LAS f32x2*)(STAT + tid * 2) = (f32x2){mean, __builtin_amdgcn_rsqf(var + EPS)}; }
        __syncthreads();
#pragma unroll
        for (int s = 0; s < 32; ++s) { const f32x2 st = *(const LAS f32x2*)(STAT + s * 2); float y = (out[s] - st.x) * st.y * lg + lb;
            y = y * __builtin_amdgcn_rcpf(1.0f + __builtin_amdgcn_exp2f(-y * LOG2E));
            AO[(size_t)(t0 + s) * D + 512 + tid] = (f16)y; }
        __syncthreads();
    }
}

namespace attn {
constexpr int KP = 208;
constexpr int SHM_K = 64 * KP, SHM_V = 64 * 64 * 2;
constexpr int LDS_V0 = 0, LDS_K0 = 2 * SHM_V, LDS_WS = 2 * SHM_V + 2 * SHM_K;
__device__ __forceinline__ int crow(int r, int hi) { return (r & 3) + 8 * (r >> 2) + 4 * hi; }
#define SBAR() __builtin_amdgcn_sched_barrier(0)
constexpr float THR = 8.0f * LOG2E;
__device__ __forceinline__ void partialSM(f32x16& p0, f32x16& p1, float& m_reg, float& mn, float& alpha) {
    float pmax = p0[0];
#pragma unroll
    for (int r = 1; r < 16; ++r) pmax = fmaxf(pmax, p0[r]);
#pragma unroll
    for (int r = 0; r < 16; ++r) pmax = fmaxf(pmax, p1[r]);
    { auto rr = __builtin_amdgcn_permlane32_swap(__float_as_uint(pmax), __float_as_uint(pmax), false, false); pmax = fmaxf(__uint_as_float(rr[0]), __uint_as_float(rr[1])); }
    if (__builtin_expect(__all(pmax - m_reg <= THR), 1)) { mn = m_reg; alpha = 1.f; }
    else { mn = fmaxf(m_reg, pmax); alpha = __builtin_amdgcn_exp2f(m_reg - mn); m_reg = mn; }
#pragma unroll
    for (int r = 0; r < 16; ++r) { p0[r] = p0[r] - mn; p1[r] = p1[r] - mn; }
#pragma unroll
    for (int r = 0; r < 16; ++r) p0[r] = __builtin_amdgcn_exp2f(p0[r]);
}
__device__ __forceinline__ void finishSM(f32x16& p0, f32x16& p1, float alpha, float& l_reg, f16x8& pa0, f16x8& pa1, f16x8& pa2, f16x8& pa3) {
#pragma unroll
    for (int r = 0; r < 16; ++r) p1[r] = __builtin_amdgcn_exp2f(p1[r]);
    float ps = 0;
#pragma unroll
    for (int r = 0; r < 16; ++r) ps += p0[r];
#pragma unroll
    for (int r = 0; r < 16; ++r) ps += p1[r];
    { auto rr = __builtin_amdgcn_permlane32_swap(__float_as_uint(ps), __float_as_uint(ps), false, false); ps = __uint_as_float(rr[0]) + __uint_as_float(rr[1]); }
    l_reg = l_reg * alpha + ps;
#define PK4(P, BASE, OUT) do { unsigned a0 = pk_h2(P[BASE + 0], P[BASE + 1]), a1 = pk_h2(P[BASE + 2], P[BASE + 3]);   \
    unsigned b0 = pk_h2(P[BASE + 4], P[BASE + 5]), b1 = pk_h2(P[BASE + 6], P[BASE + 7]);                              \
    auto r0 = __builtin_amdgcn_permlane32_swap(a0, b0, false, false); auto r1 = __builtin_amdgcn_permlane32_swap(a1, b1, false, false); \
    u32x4 w = {r0[0], r1[0], r0[1], r1[1]}; OUT = __builtin_bit_cast(f16x8, w); } while (0)
    PK4(p0, 0, pa0); PK4(p0, 8, pa1); PK4(p1, 0, pa2); PK4(p1, 8, pa3);
#undef PK4
}
__device__ __forceinline__ void qkt(f32x16& p0, f32x16& p1, const LAS char* Ks, const f16x8* qr, int r32, int hi) {
    p0 = f32x16{}; p1 = f32x16{};
#pragma unroll
    for (int d0 = 0; d0 < 6; ++d0) { const int cb = d0 * 32 + hi * 16;
        const f16x8 b0 = *(const LAS f16x8*)(Ks + r32 * KP + cb);
        const f16x8 b1 = *(const LAS f16x8*)(Ks + (32 + r32) * KP + cb);
        p0 = __builtin_amdgcn_mfma_f32_32x32x16_f16(b0, qr[d0], p0, 0, 0, 0);
        p1 = __builtin_amdgcn_mfma_f32_32x32x16_f16(b1, qr[d0], p1, 0, 0, 0); }
}
__device__ __forceinline__ int v_st(int k, int c) { const int kk = (k & ~0xC) | ((k & 4) << 1) | ((k & 8) >> 1); return ((kk >> 3) * 2 + (c >> 5)) * 512 + ((kk & 7) * 32 + (c & 31)) * 2; }
__device__ __forceinline__ int v_rd_base(int lane) { return ((lane & 3) << 3) | (((lane >> 2) & 3) << 6) | (((lane >> 4) & 1) << 5) | (((lane >> 5) & 1) << 8); }
constexpr int v_rd_off(int d0, int ks, int half) { return d0 * 512 + ks * 2048 + half * 1024; }
template <int OFF> __device__ __forceinline__ s16x4 tr_read(int vb) { s16x4 r; asm volatile("ds_read_b64_tr_b16 %0, %1 offset:%2" : "=&v"(r) : "v"(vb), "i"(OFF) : "memory"); return r; }
template <int D0> __device__ __forceinline__ void pv_one(f32x16& od, int vb, f16x8 pa0, f16x8 pa1, f16x8 pa2, f16x8 pa3) {
    const s16x4 l0 = tr_read<v_rd_off(D0, 0, 0)>(vb), h0 = tr_read<v_rd_off(D0, 0, 1)>(vb), l1 = tr_read<v_rd_off(D0, 1, 0)>(vb), h1 = tr_read<v_rd_off(D0, 1, 1)>(vb);
    const s16x4 l2 = tr_read<v_rd_off(D0, 2, 0)>(vb), h2 = tr_read<v_rd_off(D0, 2, 1)>(vb), l3 = tr_read<v_rd_off(D0, 3, 0)>(vb), h3 = tr_read<v_rd_off(D0, 3, 1)>(vb);
    asm volatile("s_waitcnt lgkmcnt(0)" ::: "memory"); SBAR();
#define PKV(L, H) __builtin_bit_cast(f16x8, (u32x4){__builtin_bit_cast(u32x2, L)[0], __builtin_bit_cast(u32x2, L)[1], __builtin_bit_cast(u32x2, H)[0], __builtin_bit_cast(u32x2, H)[1]})
    od = __builtin_amdgcn_mfma_f32_32x32x16_f16(pa0, PKV(l0, h0), od, 0, 0, 0);
    od = __builtin_amdgcn_mfma_f32_32x32x16_f16(pa1, PKV(l1, h1), od, 0, 0, 0);
    od = __builtin_amdgcn_mfma_f32_32x32x16_f16(pa2, PKV(l2, h2), od, 0, 0, 0);
    od = __builtin_amdgcn_mfma_f32_32x32x16_f16(pa3, PKV(l3, h3), od, 0, 0, 0);
#undef PKV
}
__device__ __forceinline__ void unit(const f16* __restrict__ Qb, const f16* __restrict__ Kh, const f16* __restrict__ Vh, f16* __restrict__ Ob, LAS char* lds) {
    const int tid = opaque_tid(), wid = __builtin_amdgcn_readfirstlane(tid >> 6), lane = tid & 63, r32 = lane & 31, hi = lane >> 5;
    LAS char* V_lds = lds + LDS_V0; LAS char* K_lds = lds + LDS_K0;
    LAS float* ws = (LAS float*)(lds + LDS_WS) + wid * 64; LAS float* li_l = ws; LAS float* al_l = ws + 32;
    float m_reg = -1e30f, l_reg = 0; f32x16 o[2] = {}; f16x8 qr[6];
    const f16* Qw = Qb + (size_t)(wid * 32 + r32) * 768 + hi * 8;
#pragma unroll
    for (int d0 = 0; d0 < 6; ++d0) qr[d0] = *(const GAS f16x8*)(Qw + d0 * 16);
    const int vr = tid >> 3, vc = (tid & 7) * 8, vst = v_st(vr, vc);
    const int kr0 = tid / 12, kc0 = tid % 12, kr1 = (512 + tid) / 12, kc1 = (512 + tid) % 12; const bool k2 = tid < 256;
    const int kst0 = kr0 * KP + kc0 * 16, kst1 = kr1 * KP + kc1 * 16;
    const int vb0 = (int)(uintptr_t)V_lds + v_rd_base(lane);
    struct { f16x8 vs, ks0, ks1; } sr_[2];
#define SLOAD(i, k0) do { sr_[i].vs = *(const GAS f16x8*)(Vh + (size_t)((k0) + vr) * 512 + vc); sr_[i].ks0 = *(const GAS f16x8*)(Kh + (size_t)((k0) + kr0) * 768 + kc0 * 8); \
    if (k2) sr_[i].ks1 = *(const GAS f16x8*)(Kh + (size_t)((k0) + kr1) * 768 + kc1 * 8); } while (0)
#define SWRITE(b, i) do { *(LAS f16x8*)(V_lds + (b) * SHM_V + vst) = sr_[i].vs; *(LAS f16x8*)(K_lds + (b) * SHM_K + kst0) = sr_[i].ks0; \
    if (k2) *(LAS f16x8*)(K_lds + (b) * SHM_K + kst1) = sr_[i].ks1; } while (0)
#define RESC(a) do { if (__any((a) < 1.f)) { if (hi == 0) al_l[r32] = (a); asm volatile("s_waitcnt lgkmcnt(0)" ::: "memory"); \
    _Pragma("unroll") for (int d = 0; d < 2; ++d) _Pragma("unroll") for (int r = 0; r < 16; ++r) o[d][r] *= al_l[crow(r, hi)]; } } while (0)
    f32x16 pA0, pA1, pB0, pB1; float mnA, mnB, alA, alB; f16x8 pa0, pa1, pa2, pa3; constexpr int NT = SEQ / 64;
    SLOAD(0, 0); asm volatile("s_waitcnt vmcnt(0)" ::: "memory"); SWRITE(0, 0); __syncthreads();
    qkt(pA0, pA1, K_lds, qr, r32, hi); partialSM(pA0, pA1, m_reg, mnA, alA);
    SLOAD(1, 64); SLOAD(0, 128);
    asm volatile("s_waitcnt vmcnt(3)" ::: "memory"); SWRITE(1, 1); __syncthreads();
    for (int j = 1; j + 1 < NT; j += 2) {
        SBAR(); qkt(pB0, pB1, K_lds + SHM_K, qr, r32, hi);
        finishSM(pA0, pA1, alA, l_reg, pa0, pa1, pa2, pa3); SBAR();
        SLOAD(1, (j + 2) * 64); SBAR();
        pv_one<0>(o[0], vb0, pa0, pa1, pa2, pa3); pv_one<1>(o[1], vb0, pa0, pa1, pa2, pa3); partialSM(pB0, pB1, m_reg, mnB, alB);
        __syncthreads(); asm volatile("s_waitcnt vmcnt(3)" ::: "memory"); SWRITE(0, 0);
        RESC(alB); __syncthreads();
        SBAR(); qkt(pA0, pA1, K_lds, qr, r32, hi);
        finishSM(pB0, pB1, alB, l_reg, pa0, pa1, pa2, pa3); SBAR();
        if (j + 3 < NT) SLOAD(0, (j + 3) * 64); SBAR();
        pv_one<0>(o[0], vb0 + SHM_V, pa0, pa1, pa2, pa3); pv_one<1>(o[1], vb0 + SHM_V, pa0, pa1, pa2, pa3); partialSM(pA0, pA1, m_reg, mnA, alA);
        __syncthreads(); asm volatile("s_waitcnt vmcnt(3)" ::: "memory"); SWRITE(1, 1);
        RESC(alA); __syncthreads();
    }
    SBAR(); qkt(pB0, pB1, K_lds + SHM_K, qr, r32, hi);
    finishSM(pA0, pA1, alA, l_reg, pa0, pa1, pa2, pa3); SBAR();
    pv_one<0>(o[0], vb0, pa0, pa1, pa2, pa3); pv_one<1>(o[1], vb0, pa0, pa1, pa2, pa3); partialSM(pB0, pB1, m_reg, mnB, alB);
    __syncthreads(); RESC(alB);
    finishSM(pB0, pB1, alB, l_reg, pa0, pa1, pa2, pa3); SBAR();
    pv_one<0>(o[0], vb0 + SHM_V, pa0, pa1, pa2, pa3); pv_one<1>(o[1], vb0 + SHM_V, pa0, pa1, pa2, pa3);
    if (hi == 0) li_l[r32] = l_reg; asm volatile("s_waitcnt lgkmcnt(0)" ::: "memory");
    float rli[16];
#pragma unroll
    for (int r = 0; r < 16; ++r) rli[r] = __builtin_amdgcn_rcpf(li_l[crow(r, hi)]);
    f16* Ow = Ob + (size_t)(wid * 32) * 1024;
#pragma unroll
    for (int r = 0; r < 16; ++r) { const int orow = crow(r, hi);
#pragma unroll
        for (int d0 = 0; d0 < 2; ++d0) Ow[(size_t)orow * 1024 + d0 * 32 + r32] = (f16)(o[d0][r] * rli[r]); }
    __syncthreads();
#undef SLOAD
#undef SWRITE
#undef RESC
}
__device__ __forceinline__ void unit_naive(const f16* Qb, const f16* Kh, const f16* Vh, f16* Ob) {
    const int tid = opaque_tid(); if (tid >= 256) return;
    float q[96], o[64], m = -1e30f, l = 0.f;
#pragma unroll
    for (int d = 0; d < 96; ++d) q[d] = (float)Qb[(size_t)tid * 768 + d];
#pragma unroll
    for (int d = 0; d < 64; ++d) o[d] = 0.f;
    for (int k = 0; k < SEQ; ++k) { float s = 0.f;
#pragma unroll
        for (int d = 0; d < 96; ++d) s += q[d] * (float)Kh[(size_t)k * 768 + d];
        const float mn = fmaxf(m, s), al = __builtin_amdgcn_exp2f(m - mn), p = __builtin_amdgcn_exp2f(s - mn); m = mn; l = l * al + p;
#pragma unroll
        for (int d = 0; d < 64; ++d) o[d] = o[d] * al + p * (float)Vh[(size_t)k * 512 + d]; }
    const float inv = 1.0f / l;
#pragma unroll
    for (int d = 0; d < 64; ++d) Ob[(size_t)tid * 1024 + d] = (f16)(o[d] * inv);
}
#undef SBAR
}

__device__ __forceinline__ void attn_phase(Frame& F) {
    const f16* Q = (const f16*)(F.ws + WS_Q); const f16* Kb = (const f16*)(F.ws + WS_K); const f16* V = (const f16*)(F.ws + WS_V); f16* AO = (f16*)(F.ws + WS_AO);
    for (int L = F.vcu; L < NB * 8 * 8; L += F.G) { const int bh = L >> 3, qb = L & 7, b = bh >> 3, h = bh & 7;
        const size_t r0 = (size_t)b * SEQ;
#if NAIVE_ATTN
        attn::unit_naive(Q + (r0 + qb * 256) * 768 + h * 96, Kb + r0 * 768 + h * 96, V + r0 * 512 + h * 64, AO + (r0 + qb * 256) * 1024 + h * 64);
#else
        attn::unit(Q + (r0 + qb * 256) * 768 + h * 96, Kb + r0 * 768 + h * 96, V + r0 * 512 + h * 64, AO + (r0 + qb * 256) * 1024 + h * 64, (LAS char*)F.lds);
#endif
    }
}

__device__ __forceinline__ void ln_rows(Frame& F, const float* PRE, const float* g, const float* b, f16* HH) {
    const int gw = F.vcu * NWAVES + F.wave, NGW = F.G * NWAVES, lane = F.lane;
    f32x4 gv[4], bv[4];
#pragma unroll
    for (int j = 0; j < 4; ++j) { gv[j] = *(const GAS f32x4*)(g + 4 * lane + 256 * j); bv[j] = *(const GAS f32x4*)(b + 4 * lane + 256 * j); }
    for (int row = gw; row < T; row += NGW) { const float* pr = PRE + (size_t)row * D + 4 * lane; f32x4 v[4]; float s = 0.f;
#pragma unroll
        for (int j = 0; j < 4; ++j) { v[j] = *(const GAS f32x4*)(pr + 256 * j); s += (v[j][0] + v[j][1]) + (v[j][2] + v[j][3]); }
        const float mean = wave_sum(s) * (1.0f / D); float s2 = 0.f;
#pragma unroll
        for (int j = 0; j < 4; ++j) { v[j] = v[j] - mean; s2 += (v[j][0] * v[j][0] + v[j][1] * v[j][1]) + (v[j][2] * v[j][2] + v[j][3] * v[j][3]); }
        const float rstd = __builtin_amdgcn_rsqf(wave_sum(s2) * (1.0f / D) + EPS);
#pragma unroll
        for (int j = 0; j < 4; ++j) { const f32x4 y = v[j] * rstd * gv[j] + bv[j];
            *(GAS u32x2*)(HH + (size_t)row * D + 4 * lane + 256 * j) = (u32x2){pk_h2(y[0], y[1]), pk_h2(y[2], y[3])}; } }
}
__device__ __forceinline__ void ln2_router(KArgs ap, Frame& F) { const auto& a = *ap;
    const float* PRE = (const float*)(F.ws + WS_PRE); f16* HH = (f16*)(F.ws + WS_HH); float* AFF = (float*)(F.ws + WS_AFF);
    const int gw = F.vcu * NWAVES + F.wave, NGW = F.G * NWAVES, lane = F.lane;
    LAS float* Wl = (LAS float*)F.lds;
    for (int i = F.tid; i < 1024 * 4; i += NTHR) { const int col = i >> 2, e4 = (i & 3) * 4; const f32x4 w = *(const GAS f32x4*)(a.w_router + (size_t)col * NE + e4);
        *(LAS f32x4*)(Wl + ((col >> 8) * 64 + ((col & 255) >> 2)) * 68 + (col & 3) * 16 + e4) = w; }
    __syncthreads();
    for (int r0 = gw * 2; r0 < T; r0 += NGW * 2) {
        f32x4 y[2][4];
#pragma unroll
        for (int q = 0; q < 2; ++q) { const float* pr = PRE + (size_t)(r0 + q) * D + 4 * lane; float s = 0.f;
#pragma unroll
            for (int j = 0; j < 4; ++j) { y[q][j] = *(const GAS f32x4*)(pr + 256 * j); s += (y[q][j][0] + y[q][j][1]) + (y[q][j][2] + y[q][j][3]); }
            const float mean = wave_sum(s) * (1.0f / D); float s2 = 0.f;
#pragma unroll
            for (int j = 0; j < 4; ++j) { y[q][j] = y[q][j] - mean; s2 += (y[q][j][0] * y[q][j][0] + y[q][j][1] * y[q][j][1]) + (y[q][j][2] * y[q][j][2] + y[q][j][3] * y[q][j][3]); }
            const float rstd = __builtin_amdgcn_rsqf(wave_sum(s2) * (1.0f / D) + EPS);
#pragma unroll
            for (int j = 0; j < 4; ++j) { const f32x4 gv = *(const GAS f32x4*)(a.ln2_g + 4 * lane + 256 * j), bv = *(const GAS f32x4*)(a.ln2_b + 4 * lane + 256 * j);
                y[q][j] = y[q][j] * rstd * gv + bv;
                *(GAS u32x2*)(HH + (size_t)(r0 + q) * D + 4 * lane + 256 * j) = (u32x2){pk_h2(y[q][j][0], y[q][j][1]), pk_h2(y[q][j][2], y[q][j][3])}; }
            asm volatile("" ::: "memory"); }
        float part[32];
#pragma unroll
        for (int k = 0; k < 32; ++k) part[k] = 0.f;
#pragma unroll
        for (int j = 0; j < 4; ++j) { const LAS float* wl = Wl + (j * 64 + lane) * 68;
#pragma unroll
            for (int cc = 0; cc < 4; ++cc) { const LAS float* wp = wl + cc * 16;
                const f32x4 w0 = *(const LAS f32x4*)wp, w1 = *(const LAS f32x4*)(wp + 4), w2 = *(const LAS f32x4*)(wp + 8), w3 = *(const LAS f32x4*)(wp + 12);
#pragma unroll
                for (int q = 0; q < 2; ++q) { const float hv = y[q][j][cc];
#pragma unroll
                    for (int e = 0; e < 4; ++e) { part[q * 16 + e] += hv * w0[e]; part[q * 16 + 4 + e] += hv * w1[e]; part[q * 16 + 8 + e] += hv * w2[e]; part[q * 16 + 12 + e] += hv * w3[e]; } }
                if (cc & 1) asm volatile("" ::: "memory"); } }
#define RSTEP(N, BIT) _Pragma("unroll") for (int k = 0; k < N; ++k) { const bool up = (lane >> BIT) & 1; const float send = up ? part[k] : part[k + N], keep = up ? part[k + N] : part[k]; part[k] = keep + __shfl_xor(send, 1 << BIT); }
        RSTEP(16, 4) RSTEP(8, 3) RSTEP(4, 2) RSTEP(2, 1) RSTEP(1, 0)
#undef RSTEP
        float lg = part[0] + __shfl_xor(part[0], 32), mx = lg;
#pragma unroll
        for (int o = 1; o < 16; o <<= 1) mx = fmaxf(mx, __shfl_xor(mx, o));
        const float p = __builtin_amdgcn_exp2f((lg - mx) * LOG2E); float sm = p;
#pragma unroll
        for (int o = 1; o < 16; o <<= 1) sm += __shfl_xor(sm, o);
        if (lane < 32) AFF[(size_t)r0 * NE + lane] = p / sm;
    }
}
__device__ __forceinline__ void topk_phase(Frame& F) {
    LAS unsigned* cnt = (LAS unsigned*)F.lds;
    LAS unsigned* wtot = (LAS unsigned*)(F.lds + 256);
    LAS int* lst = (LAS int*)(F.lds + 1024);
    const float* AFF = (const float*)(F.ws + WS_AFF); float* GATE = (float*)(F.ws + WS_GATE); int* SLOT = (int*)(F.ws + WS_SLOT);
    const f16* HH = (const f16*)(F.ws + WS_HH); f16* XS = (f16*)(F.ws + WS_XS);
    const int lane = F.lane, wave = F.wave;
    for (int item = F.vcu; item < NB * NE * 2; item += F.G) { const int half = item & 1, e = (item >> 1) & 15, b = item >> 5;
        float val[4]; unsigned key[4];
#pragma unroll
        for (int k = 0; k < 4; ++k) { val[k] = AFF[(size_t)(b * SEQ + wave * 256 + k * 64 + lane) * NE + e]; key[k] = __float_as_uint(val[k]); }
        unsigned t = 0u;
        for (int bit = 30; bit >= 0; --bit) { const unsigned cand = t | (1u << bit); unsigned c = 0u;
#pragma unroll
            for (int k = 0; k < 4; ++k) c += (unsigned)__builtin_popcountll(__ballot(key[k] >= cand));
            if (lane == 0) cnt[(bit & 1) * 8 + wave] = c;
            asm volatile("s_waitcnt lgkmcnt(0)" ::: "memory"); __builtin_amdgcn_s_barrier(); asm volatile("" ::: "memory");
            const u32x4 c0 = *(const LAS u32x4*)(cnt + (bit & 1) * 8), c1 = *(const LAS u32x4*)(cnt + (bit & 1) * 8 + 4);
            const unsigned tot = (c0[0] + c0[1]) + (c0[2] + c0[3]) + (c1[0] + c1[1]) + (c1[2] + c1[3]);
            if (tot >= (unsigned)CAP) t = cand; }
        unsigned long long bg[4], be[4]; unsigned tg = 0u, te = 0u;
#pragma unroll
        for (int k = 0; k < 4; ++k) { bg[k] = __ballot(key[k] > t); be[k] = __ballot(key[k] == t); tg += (unsigned)__builtin_popcountll(bg[k]); te += (unsigned)__builtin_popcountll(be[k]); }
        if (lane == 0) { wtot[wave * 2] = tg; wtot[wave * 2 + 1] = te; }
        asm volatile("s_waitcnt lgkmcnt(0)" ::: "memory"); __builtin_amdgcn_s_barrier(); asm volatile("" ::: "memory");
        unsigned gbase = 0u, ebase = 0u, gall = 0u;
#pragma unroll
        for (int w = 0; w < 8; ++w) { const unsigned a = wtot[w * 2], q = wtot[w * 2 + 1]; gall += a; if (w < wave) { gbase += a; ebase += q; } }
        const unsigned need = (unsigned)CAP - gall;
        const unsigned long long below = (1ull << lane) - 1ull;
#pragma unroll
        for (int k = 0; k < 4; ++k) { const int i = wave * 256 + k * 64 + lane;
            const unsigned gb = gbase + (unsigned)__builtin_popcountll(bg[k] & below), eb = ebase + (unsigned)__builtin_popcountll(be[k] & below);
            const bool isg = (bg[k] >> lane) & 1ull, ise = (be[k] >> lane) & 1ull;
            const bool sel = isg || (ise && eb < need); const unsigned slot = gb + (eb < need ? eb : need);
            if (half == 0) SLOT[(size_t)(b * SEQ + i) * NE + e] = sel ? (int)slot : -1;
            if (sel) { lst[slot] = i; if (half == 0) GATE[(size_t)(b * NE + e) * CAP + slot] = val[k]; }
            gbase += (unsigned)__builtin_popcountll(bg[k]); ebase += (unsigned)__builtin_popcountll(be[k]); }
        asm volatile("s_waitcnt lgkmcnt(0)" ::: "memory"); __builtin_amdgcn_s_barrier(); asm volatile("" ::: "memory");
#pragma unroll 1
        for (int q = 0; q < 16; q += 4) { u32x4 p[4][2]; int r[4];
#pragma unroll
            for (int j = 0; j < 4; ++j) { r[j] = half * 128 + wave * 16 + q + j; const f16* src = HH + (size_t)(b * SEQ + lst[r[j]]) * D;
                p[j][0] = *(const GAS u32x4*)(src + lane * 8); p[j][1] = *(const GAS u32x4*)(src + 512 + lane * 8); }
#pragma unroll
            for (int j = 0; j < 4; ++j) { f16* dst = XS + ((size_t)e * 2048 + b * CAP + r[j]) * D;
                *(GAS u32x4*)(dst + lane * 8) = p[j][0]; *(GAS u32x4*)(dst + 512 + lane * 8) = p[j][1]; } }
        asm volatile("s_waitcnt lgkmcnt(0)" ::: "memory"); __builtin_amdgcn_s_barrier(); asm volatile("" ::: "memory");
    }
}
__device__ __forceinline__ void combine_ln3(KArgs ap, Frame& F) { const auto& a = *ap;
    const f16* HH = (const f16*)(F.ws + WS_HH); const f16* Y = (const f16*)(F.ws + WS_Y); const int* SLOT = (const int*)(F.ws + WS_SLOT);
    const int gw = F.vcu * NWAVES + F.wave, NGW = F.G * NWAVES, lane = F.lane;
    f32x4 gv[4], bv[4];
#pragma unroll
    for (int j = 0; j < 4; ++j) { gv[j] = *(const GAS f32x4*)(a.ln3_g + 4 * lane + 256 * j); bv[j] = *(const GAS f32x4*)(a.ln3_b + 4 * lane + 256 * j); }
    for (int row = gw; row < T; row += NGW) { const int b = row / SEQ; f32x4 v[4];
#pragma unroll
        for (int j = 0; j < 4; ++j) { const f16x4 hv = *(const GAS f16x4*)(HH + (size_t)row * D + 4 * lane + 256 * j); v[j] = (f32x4){(float)hv[0], (float)hv[1], (float)hv[2], (float)hv[3]} * ALPHA; }
        const int sl = (lane < NE) ? SLOT[(size_t)row * NE + lane] : -1;
        for (int e = 0; e < NE; ++e) { const int s = __builtin_amdgcn_readlane(sl, e); if (s < 0) continue;
            const f16* yp = Y + ((size_t)e * 2048 + b * CAP + s) * D + 4 * lane;
#pragma unroll
            for (int j = 0; j < 4; ++j) { const f16x4 yv = *(const GAS f16x4*)(yp + 256 * j); v[j] += (f32x4){(float)yv[0], (float)yv[1], (float)yv[2], (float)yv[3]}; } }
        float s = 0.f;
#pragma unroll
        for (int j = 0; j < 4; ++j) s += (v[j][0] + v[j][1]) + (v[j][2] + v[j][3]);
        const float mean = wave_sum(s) * (1.0f / D); float s2 = 0.f;
#pragma unroll
        for (int j = 0; j < 4; ++j) { v[j] = v[j] - mean; s2 += (v[j][0] * v[j][0] + v[j][1] * v[j][1]) + (v[j][2] * v[j][2] + v[j][3] * v[j][3]); }
        const float rstd = __builtin_amdgcn_rsqf(wave_sum(s2) * (1.0f / D) + EPS);
#pragma unroll
        for (int j = 0; j < 4; ++j) *(GAS f32x4*)(a.out + (size_t)row * D + 4 * lane + 256 * j) = v[j] * rstd * gv[j] + bv[j];
    }
}

constexpr int NPHASE = 14;
__global__ void __launch_bounds__(NTHR, 2) fwd(Args args) {
    extern __shared__ __attribute__((aligned(16))) unsigned char lds_raw[];
    Frame F; F.lds = (LAS unsigned char*)lds_raw; F.tid = threadIdx.x; F.lane = F.tid & 63; F.wave = __builtin_amdgcn_readfirstlane(F.tid >> 6);
    F.G = gridDim.x; { const int bx = blockIdx.x; F.vcu = (F.G % 8 == 0) ? (bx % 8) * (F.G / 8) + bx / 8 : bx; }
    KArgs kp = (KArgs)__builtin_amdgcn_kernarg_segment_ptr();
#define KP() ({ KArgs p_ = kp; asm volatile("" : "+s"(p_)); p_; })
    F.ws = kp->ws;
    unsigned char* ws = F.ws;
    volatile LAS unsigned* MISC = (volatile LAS unsigned*)(F.lds + MISC_OFF);
    for (int u = F.tid; u < (LDS_BYTES - RING_BYTES) / 4; u += NTHR) ((LAS unsigned*)(F.lds + RING_BYTES))[u] = 0u;
    __syncthreads();
    const int lo = kp->ph_lo, hi = kp->ph_hi;
    XcdBarrier bar; bar.bar = (unsigned*)(ws + WS_CTL) + CW_BAR; bar.x = 0; bar.st = nullptr;
    if (hi - lo > 1) bar = xcd_barrier_post((unsigned*)(ws + WS_CTL) + CW_BAR, MISC + 8);
#ifdef ONLY_PH
#define IN(k) ((k) == ONLY_PH && lo <= (k) && (k) < hi)
#else
#define IN(k) (lo <= (k) && (k) < hi)
#endif
#define REPS(k) for (int rep_ = 0; rep_ <= ((DUP_MASK >> (k)) & 1); ++rep_)
#ifndef DUP_BAR
#define DUP_BAR 0
#endif
#define SEAM(k) do { if (IN(k) && IN((k) + 1)) { xcd_barrier(bar); if (DUP_BAR) xcd_barrier(bar); } } while (0)
    const char* wsc = (const char*)ws;
    float* RS = (float*)(ws + WS_CTL) + CW_RS;

    if (IN(0)) REPS(0) { frame_ids(F); p0_prologue(KP(), F); } SEAM(0);

    if (IN(1)) REPS(1) { frame_ids(F);
        SchedG1 S{F.vcu, F.G, wsc + WS_XH, wsc + WS_WIN, wsc + WS_MEMH, wsc + WS_XWK, wsc + WS_XWV};
        EpiG1 E{(f16*)(ws + WS_HCAT), (f16*)(ws + WS_MK), (f16*)(ws + WS_MVT), rep_ ? (float*)(ws + 30 * MiB) : RS};
        pg8::gemm_phase<EpiG1, SchedG1, true>(F.lds, pg8::Gemm{1024, 1024, 1024}, S, E);
    } SEAM(1);

    if (IN(2)) REPS(2) { frame_ids(F);
        SchedGrid S{F.vcu, F.G, 7, 448, wsc + WS_HCAT, wsc + WS_WUP, (size_t)256 * LDH * 2, (size_t)256 * 384 * 2};
        EpiUP E{(f16*)(ws + WS_Q), (f16*)(ws + WS_K), (f16*)(ws + WS_V), RS, (const float*)(ws + WS_CS)};
        pg8::gemm_phase<EpiUP, SchedGrid, true>(F.lds, pg8::Gemm{LDH, 384, 384}, S, E);
        krope_pass(F);
        conv_phase(KP(), F);
    } SEAM(2);

    if (IN(3)) REPS(3) { frame_ids(F); attn_phase(F); } SEAM(3);

    if (IN(4)) REPS(4) { frame_ids(F);
        SchedGrid S{F.vcu, F.G, 4, 256, wsc + WS_AO, wsc + WS_WO, (size_t)256 * 1024 * 2, (size_t)256 * 1024 * 2};
        EpiPre E{(const f16*)(ws + WS_XH), (float*)(ws + WS_PRE)};
        pg8::gemm_phase<EpiPre, SchedGrid, true>(F.lds, pg8::Gemm{1024, 1024, 1024}, S, E);
    } SEAM(4);

    if (IN(5)) REPS(5) { frame_ids(F); ln_rows(F, (const float*)(ws + WS_PRE), KP()->ln1_g, KP()->ln1_b, (f16*)(ws + WS_HH)); } SEAM(5);

    if (IN(6)) REPS(6) { frame_ids(F);
        { SchedXS S{F.vcu, F.G, wsc + WS_HH, wsc + WS_XWQ, 2}; EpiH16 E{(f16*)(ws + WS_XQ), 1024, XSCALE};
          pg8::gemm_phase<EpiH16, SchedXS, true>(F.lds, pg8::Gemm{1024, 1024, 1024}, S, E); }
        VM_WAIT(); __syncthreads();
        { SchedXS S{F.vcu, F.G, wsc + WS_XQ, wsc + WS_MK, 0}; EpiSoftmax E{(f16*)(ws + WS_P)};
          pg8::gemm_phase<EpiSoftmax, SchedXS, false>(F.lds, pg8::Gemm{1024, 1024, 256}, S, E); }
        VM_WAIT(); __syncthreads();
        { SchedXS S{F.vcu, F.G, wsc + WS_P, wsc + WS_MVT, 1}; EpiH16 E{(f16*)(ws + WS_XO), 1024, 1.0f};
          pg8::gemm_phase<EpiH16, SchedXS, true>(F.lds, pg8::Gemm{1024, MT, 256}, S, E); }
    } SEAM(6);

    if (IN(8)) REPS(8) { frame_ids(F);
        SchedGrid S{F.vcu, F.G, 4, 256, wsc + WS_XO, wsc + WS_XWO, (size_t)256 * 1024 * 2, (size_t)256 * 1024 * 2};
        EpiPre E{(const f16*)(ws + WS_HH), (float*)(ws + WS_PRE)};
        pg8::gemm_phase<EpiPre, SchedGrid, true>(F.lds, pg8::Gemm{1024, 1024, 1024}, S, E);
    } SEAM(8);

    if (IN(9)) REPS(9) { frame_ids(F); ln2_router(KP(), F); } SEAM(9);

    if (IN(10)) REPS(10) { frame_ids(F); topk_phase(F); } SEAM(10);

    if (IN(11)) REPS(11) { frame_ids(F);
        SchedMoE S{F.vcu, F.G, 16, 2048, wsc + WS_XS, wsc + WS_WGU, (size_t)2048 * 1024 * 2, (size_t)4096 * 1024 * 2, (size_t)256 * 1024 * 2, (size_t)256 * 1024 * 2};
        EpiHid E{(f16*)(ws + WS_HID)};
        pg8::gemm_phase<EpiHid, SchedMoE, true>(F.lds, pg8::Gemm{1024, 1024, 1024}, S, E);
    } SEAM(11);

    if (IN(12)) REPS(12) { frame_ids(F);
        SchedMoE S{F.vcu, F.G, 4, 512, wsc + WS_HID, wsc + WS_WD, (size_t)2048 * 2048 * 2, (size_t)1024 * 2048 * 2, (size_t)256 * 2048 * 2, (size_t)256 * 2048 * 2};
        EpiY E{(f16*)(ws + WS_Y), (const float*)(ws + WS_GATE)};
        pg8::gemm_phase<EpiY, SchedMoE, true>(F.lds, pg8::Gemm{2048, 2048, 2048}, S, E);
    } SEAM(12);

    if (IN(13)) REPS(13) { frame_ids(F); combine_ln3(KP(), F); }
#undef IN
#undef SEAM
}

extern "C" void kernel_launch(void* const* d_in, const int* in_sizes, int n_in, void* d_out, int out_size, void* d_ws, size_t ws_size, hipStream_t stream) {
    static int ok = 0;
    if (ok == 0) {
        if (n_in != 28 || in_sizes[0] != T * D || out_size != T * D || ws_size < WS_END) {
            fprintf(stderr, "kernel_launch: shape mismatch: n_in %d in0 %d out %d ws %zu (need %zu)\n", n_in, n_in > 0 ? in_sizes[0] : -1, out_size, ws_size, (size_t)WS_END); ok = -1; return; }
        if (hipFuncSetAttribute((const void*)fwd, hipFuncAttributeMaxDynamicSharedMemorySize, LDS_BYTES) != hipSuccess) { fprintf(stderr, "kernel_launch: hipFuncSetAttribute failed\n"); ok = -1; return; }
        int per_cu = 0;
        if (hipOccupancyMaxActiveBlocksPerMultiprocessor(&per_cu, (const void*)fwd, NTHR, LDS_BYTES) != hipSuccess || per_cu < 1) fprintf(stderr, "kernel_launch: occupancy query reports %d blocks per CU\n", per_cu);
        (void)hipGetLastError();
        ok = 1;
    }
    if (ok < 0) return;
    (void)hipMemsetAsync((char*)d_ws + WS_CTL, 0, CTL_BYTES, stream);
    Args a{};
    a.x = (const float*)d_in[0]; a.mem = (const float*)d_in[1]; a.pos = (const int*)d_in[2]; a.w_in = (const float*)d_in[3]; a.q_norm_g = (const float*)d_in[4]; a.w_uq = (const float*)d_in[5];
    a.kv_norm_g = (const float*)d_in[6]; a.w_uk = (const float*)d_in[7]; a.w_uv = (const float*)d_in[8]; a.conv_w = (const float*)d_in[9]; a.conv_b = (const float*)d_in[10];
    a.conv_ln_g = (const float*)d_in[11]; a.conv_ln_b = (const float*)d_in[12]; a.w_o = (const float*)d_in[13]; a.ln1_g = (const float*)d_in[14]; a.ln1_b = (const float*)d_in[15];
    a.xa_w_q = (const float*)d_in[16]; a.xa_w_k = (const float*)d_in[17]; a.xa_w_v = (const float*)d_in[18]; a.xa_w_o = (const float*)d_in[19]; a.ln2_g = (const float*)d_in[20]; a.ln2_b = (const float*)d_in[21];
    a.w_router = (const float*)d_in[22]; a.w_gate = (const float*)d_in[23]; a.w_up = (const float*)d_in[24]; a.w_down = (const float*)d_in[25]; a.ln3_g = (const float*)d_in[26]; a.ln3_b = (const float*)d_in[27];
    a.out = (float*)d_out; a.ws = (unsigned char*)d_ws;
    for (int i = 0; i < 16; ++i) a.invf[i] = powf(10000.0f, -(float)(2 * i) / 32.0f);
#if MK_N_LAUNCHES == 1
    a.ph_lo = 0; a.ph_hi = NPHASE;
    hipLaunchKernelGGL(fwd, dim3(GRID), dim3(NTHR), LDS_BYTES, stream, a);
#else
    for (int p = 0; p < NPHASE; ++p) { a.ph_lo = p; a.ph_hi = p + 1; hipLaunchKernelGGL(fwd, dim3(GRID), dim3(NTHR), LDS_BYTES, stream, a); }
#endif
    const hipError_t le = hipPeekAtLastError();
    if (le != hipSuccess) fprintf(stderr, "kernel_launch: launch failed: %s\n", hipGetErrorName(le));
}
```
